# Optimizing an MI355X kernel written in HIP

```python
import math
import jax, jax.numpy as jnp
from jax import lax
import numpy as np

D_MODEL = 2048
BATCH = 4
SEQ = 4096
DEPTH = 4

CHUNK = 64
Q_BLOCK = 128
N_MEM = 256
D_MIX = D_MODEL
LRU_WIDTH = D_MIX // 2
LRU_BLOCKS = 8
LRU_BLOCK_W = LRU_WIDTH // LRU_BLOCKS
CONV_W = 4
RGLRU_C = 8.0
DIFF_HEADS = 4
DIFF_DH = D_MIX // 4 // (2 * DIFF_HEADS)
DIFF_VD = 2 * DIFF_DH
FOX_HEADS = 4
FOX_DH = D_MIX // 4 // FOX_HEADS
XATTN_HEADS = 4
XATTN_DH = D_MODEL // XATTN_HEADS
D_FF = ((8 * D_MODEL // 3 + 255) // 256) * 256
FFN_RESIDUAL_WEIGHT = 0.5
REL_BUCKETS = 32
REL_MAX_DIST = 128
NORM_EPS = 1e-6
NEG_INF = -1e30
N_NORMS = 8

IN_SIZES = (
    LRU_WIDTH, LRU_WIDTH,
    DIFF_HEADS * 2 * DIFF_DH, DIFF_HEADS * 2 * DIFF_DH, DIFF_HEADS * DIFF_VD,
    FOX_HEADS * FOX_DH, FOX_HEADS * FOX_DH, FOX_HEADS * FOX_DH,
    FOX_HEADS,
)
D_IN = sum(IN_SIZES)
IN_SPLITS = tuple(int(v) for v in np.cumsum(IN_SIZES)[:-1])
D_CAT = LRU_WIDTH + DIFF_HEADS * DIFF_VD + FOX_HEADS * FOX_DH

kernel_name = "hybrid_rglru_diffattn_fox_macaron"


def rms_norm(x, g):
    x32 = x.astype(jnp.float32)
    return x32 * lax.rsqrt(jnp.mean(x32 * x32, axis=-1, keepdims=True) + NORM_EPS) * g


def swiglu(h, w_in, w_out):
    gate, up = jnp.split(h @ w_in, 2, axis=-1)
    return (jax.nn.silu(gate) * up) @ w_out


def causal_conv(x, w, b):
    S = x.shape[1]
    xp = jnp.pad(x, ((0, 0), (CONV_W - 1, 0), (0, 0)))
    return b + sum(xp[:, k:k + S] * w[k] for k in range(CONV_W))


def _linear_recurrence_combine(c1, c2):
    a1, b1 = c1
    a2, b2 = c2
    return a1 * a2, a2 * b1 + b2


def rg_lru(x, gate_w, gate_b, lam):
    B, S, W = x.shape
    xb = x.reshape(B, S, LRU_BLOCKS, LRU_BLOCK_W)
    gates = jnp.einsum('bsnd,gnde->gbsne', xb, gate_w).reshape(2, B, S, W) + gate_b[:, None, None, :]
    r = jax.nn.sigmoid(gates[0])
    i = jax.nn.sigmoid(gates[1])
    log_a = -RGLRU_C * r * jax.nn.softplus(-lam)
    a = jnp.exp(log_a)
    b = jnp.sqrt(-jnp.expm1(2.0 * log_a)) * (i * x)
    _, hs = lax.associative_scan(_linear_recurrence_combine, (a, b), axis=1)
    return hs


def t5_bucket(rel):
    nb = REL_BUCKETS // 2
    max_exact = nb // 2
    n = jnp.abs(rel)
    large = max_exact + (jnp.log(jnp.maximum(n, max_exact).astype(jnp.float32) / max_exact)
                         / math.log(REL_MAX_DIST / max_exact) * (nb - max_exact)).astype(jnp.int32)
    large = jnp.minimum(large, nb - 1)
    return jnp.where(rel > 0, nb, 0) + jnp.where(n < max_exact, n, large)


def diff_attention(q, k, v, lam, rel_bias):
    B, S = q.shape[:2]
    scale = DIFF_DH ** -0.5
    kpos = jnp.arange(S)

    def block(i):
        start = i * Q_BLOCK
        qb = lax.dynamic_slice_in_dim(q, start, Q_BLOCK, axis=1)
        qpos = start + jnp.arange(Q_BLOCK)
        bias = rel_bias[t5_bucket(kpos[None, :] - qpos[:, None])].transpose(2, 0, 1)
        allowed = (kpos[None, :] // CHUNK) <= (qpos[:, None] // CHUNK)
        logits = jnp.einsum('bqhcd,bkhcd->bchqk', qb, k) * scale + bias[None, None]
        p = jax.nn.softmax(jnp.where(allowed, logits, NEG_INF), axis=-1)
        attn = p[:, 0] - lam * p[:, 1]
        return jnp.einsum('bhqk,bkhe->bqhe', attn, v)

    out = lax.map(block, jnp.arange(S // Q_BLOCK))
    return out.transpose(1, 0, 2, 3, 4).reshape(B, S, DIFF_HEADS, DIFF_VD)


def forgetting_attention(q, k, v, log_f):
    B, S = q.shape[:2]
    scale = FOX_DH ** -0.5
    cum = jnp.cumsum(log_f, axis=1).transpose(0, 2, 1)
    kpos = jnp.arange(S)

    def block(i):
        start = i * Q_BLOCK
        qb = lax.dynamic_slice_in_dim(q, start, Q_BLOCK, axis=1)
        cq = lax.dynamic_slice_in_dim(cum, start, Q_BLOCK, axis=2)
        qpos = start + jnp.arange(Q_BLOCK)
        allowed = kpos[None, :] <= qpos[:, None]
        logits = jnp.einsum('bqhd,bkhd->bhqk', qb, k) * scale + cq[..., :, None] - cum[..., None, :]
        p = jax.nn.softmax(jnp.where(allowed, logits, NEG_INF), axis=-1)
        return jnp.einsum('bhqk,bkhd->bqhd', p, v)

    out = lax.map(block, jnp.arange(S // Q_BLOCK))
    return out.transpose(1, 0, 2, 3, 4).reshape(B, S, FOX_HEADS, FOX_DH)


def token_mixer(h, w_in, conv_w, conv_b, gate_w, gate_b, lru_lambda, diff_lambda, subln_g,
                f_bias, rel_bias, w_out, lam_init):
    B, S, _ = h.shape
    a_x, a_y, dq, dk, dv, fq, fk, fv, fl = jnp.split(h @ w_in, IN_SPLITS, axis=-1)
    a_out = rg_lru(causal_conv(a_x, conv_w, conv_b), gate_w, gate_b, lru_lambda) * jax.nn.gelu(a_y)
    lam = (jnp.exp(jnp.sum(diff_lambda[0] * diff_lambda[1]))
           - jnp.exp(jnp.sum(diff_lambda[2] * diff_lambda[3])) + lam_init)
    d_out = diff_attention(dq.reshape(B, S, DIFF_HEADS, 2, DIFF_DH),
                           dk.reshape(B, S, DIFF_HEADS, 2, DIFF_DH),
                           dv.reshape(B, S, DIFF_HEADS, DIFF_VD), lam, rel_bias)
    d_out = rms_norm(d_out, subln_g) * (1.0 - lam_init)
    log_f = jax.nn.log_sigmoid(fl + f_bias)
    f_out = forgetting_attention(fq.reshape(B, S, FOX_HEADS, FOX_DH), fk.reshape(B, S, FOX_HEADS, FOX_DH),
                                 fv.reshape(B, S, FOX_HEADS, FOX_DH), log_f)
    cat = jnp.concatenate([a_out, d_out.reshape(B, S, -1), f_out.reshape(B, S, -1)], axis=-1)
    return cat @ w_out


def memory_cross_attention(h, mem, w_q, w_kv, w_o):
    B, S, _ = h.shape
    M = mem.shape[1]
    q = (h @ w_q).reshape(B, S, XATTN_HEADS, XATTN_DH)
    k, v = jnp.split(mem @ w_kv, 2, axis=-1)
    k = k.reshape(B, M, XATTN_HEADS, XATTN_DH)
    v = v.reshape(B, M, XATTN_HEADS, XATTN_DH)
    p = jax.nn.softmax(jnp.einsum('bqhd,bkhd->bhqk', q, k) * XATTN_DH ** -0.5, axis=-1)
    return jnp.einsum('bhqk,bkhd->bqhd', p, v).reshape(B, S, D_MODEL) @ w_o


def setup_inputs(seed: int = 0) -> dict:
    key = jax.random.key(seed)
    ks = jax.random.split(key, 22)
    nrm = jax.random.normal
    f32 = jnp.float32
    u = jax.random.uniform(ks[10], (DEPTH, LRU_WIDTH), f32, 0.9, 0.999)
    p = u ** (1.0 / RGLRU_C)
    return {
        "x": nrm(ks[0], (BATCH, SEQ, D_MODEL), f32),
        "mem": nrm(ks[1], (BATCH, N_MEM, D_MODEL), f32),
        "norm_g": 1.0 + 0.05 * nrm(ks[2], (DEPTH, N_NORMS, D_MODEL), f32),
        "ffn1_w_in": nrm(ks[3], (DEPTH, D_MODEL, 2 * D_FF), f32) * D_MODEL ** -0.5,
        "ffn1_w_out": nrm(ks[4], (DEPTH, D_FF, D_MODEL), f32) * D_FF ** -0.5,
        "w_in": nrm(ks[5], (DEPTH, D_MODEL, D_IN), f32) * D_MODEL ** -0.5,
        "conv_w": nrm(ks[6], (DEPTH, CONV_W, LRU_WIDTH), f32) * CONV_W ** -0.5,
        "conv_b": 0.01 * nrm(ks[7], (DEPTH, LRU_WIDTH), f32),
        "lru_gate_w": nrm(ks[8], (DEPTH, 2, LRU_BLOCKS, LRU_BLOCK_W, LRU_BLOCK_W), f32) * LRU_BLOCK_W ** -0.5,
        "lru_gate_b": 0.01 * nrm(ks[9], (DEPTH, 2, LRU_WIDTH), f32),
        "lru_lambda": jnp.log(p) - jnp.log1p(-p),
        "diff_lambda": 0.1 * nrm(ks[11], (DEPTH, 4, DIFF_DH), f32),
        "diff_subln_g": 1.0 + 0.05 * nrm(ks[12], (DEPTH, DIFF_VD), f32),
        "fox_f_bias": jax.random.uniform(ks[13], (DEPTH, FOX_HEADS), f32, 1.0, 5.0),
        "rel_bias": 0.5 * nrm(ks[14], (REL_BUCKETS, DIFF_HEADS), f32),
        "w_out": nrm(ks[15], (DEPTH, D_CAT, D_MODEL), f32) * D_CAT ** -0.5,
        "xattn_w_q": nrm(ks[16], (DEPTH, D_MODEL, D_MODEL), f32) * D_MODEL ** -0.5,
        "xattn_w_kv": nrm(ks[17], (DEPTH, D_MODEL, 2 * D_MODEL), f32) * D_MODEL ** -0.5,
        "xattn_w_o": nrm(ks[18], (DEPTH, D_MODEL, D_MODEL), f32) * D_MODEL ** -0.5,
        "ffn2_w_in": nrm(ks[19], (DEPTH, D_MODEL, 2 * D_FF), f32) * D_MODEL ** -0.5,
        "ffn2_w_out": nrm(ks[20], (DEPTH, D_FF, D_MODEL), f32) * D_FF ** -0.5,
    }


def reference(x, mem, norm_g, ffn1_w_in, ffn1_w_out, w_in, conv_w, conv_b, lru_gate_w, lru_gate_b,
              lru_lambda, diff_lambda, diff_subln_g, fox_f_bias, rel_bias, w_out, xattn_w_q,
              xattn_w_kv, xattn_w_o, ffn2_w_in, ffn2_w_out):
    out_dtype = x.dtype
    h = x.astype(jnp.float32)
    mem32 = mem.astype(jnp.float32)
    for l in range(DEPTH):
        g = norm_g[l]
        lam_init = 0.8 - 0.6 * math.exp(-0.3 * l)
        h = h + FFN_RESIDUAL_WEIGHT * rms_norm(swiglu(rms_norm(h, g[0]), ffn1_w_in[l], ffn1_w_out[l]), g[1])
        mix = token_mixer(rms_norm(h, g[2]), w_in[l], conv_w[l], conv_b[l], lru_gate_w[l], lru_gate_b[l],
                          lru_lambda[l], diff_lambda[l], diff_subln_g[l], fox_f_bias[l], rel_bias,
                          w_out[l], lam_init)
        h = h + rms_norm(mix, g[3])
        h = h + rms_norm(memory_cross_attention(rms_norm(h, g[4]), mem32, xattn_w_q[l], xattn_w_kv[l],
                                                xattn_w_o[l]), g[5])
        h = h + FFN_RESIDUAL_WEIGHT * rms_norm(swiglu(rms_norm(h, g[6]), ffn2_w_in[l], ffn2_w_out[l]), g[7])
    return h.astype(out_dtype)
```

```cpp
#include <hip/hip_runtime.h>
#include <cstdio>
#include <cstdint>

#ifndef PROBE_DUP
#define PROBE_DUP 0u
#endif
#ifndef MK_ONE_LAUNCH
#define MK_ONE_LAUNCH 1
#endif

#define LAS __attribute__((address_space(3)))
#define GAS __attribute__((address_space(1)))
typedef unsigned short bf16;
typedef short bf16x8 __attribute__((ext_vector_type(8)));
typedef short s16x4 __attribute__((ext_vector_type(4)));
typedef float f32x2 __attribute__((ext_vector_type(2)));
typedef float f32x4 __attribute__((ext_vector_type(4)));
typedef float f32x16 __attribute__((ext_vector_type(16)));
typedef unsigned u32x2 __attribute__((ext_vector_type(2)));
typedef unsigned u32x4 __attribute__((ext_vector_type(4)));
typedef GAS unsigned gu32;

constexpr int BATCH = 4, SEQ = 4096, M = BATCH * SEQ, DM = 2048, DEPTH = 4, DFF = 5632, DIN = 5124, DINP = 5120, NMEM = 256, MROWS = BATCH * NMEM;
constexpr int LRUW = 1024;
constexpr float EPS = 1e-6f;
constexpr int C_AX = 0, C_AY = 1024, C_DQ = 2048, C_DK = 2560, C_DV = 3072, C_FQ = 3584, C_FK = 4096, C_FV = 4608;
constexpr int CC_LRU = 0, CC_DIFF = 1024, CC_FOX = 1536;
constexpr float SCALE_FOX = 0.08838834764831845f, SCALE_DIFF = 0.125f, SCALE_X = 0.04419417382415922f;

constexpr size_t MiB = 1u << 20;
constexpr size_t WS_CTL = 0, CTL_ZERO_BYTES = 1 * MiB;
constexpr size_t WS_W1I = 1 * MiB, WS_W1O = 177 * MiB, WS_W2I = 265 * MiB, WS_W2O = 441 * MiB, WS_WIN = 529 * MiB, WS_WOUT = 609 * MiB, WS_GW = 641 * MiB;
constexpr size_t WS_G = 643 * MiB, WS_UT = 707 * MiB, WS_XN = 771 * MiB, WS_HFF = 835 * MiB, WS_CAT = 1011 * MiB, WS_PB = 1075 * MiB, WS_Y = 1107 * MiB;
constexpr size_t WS_D1 = 1235 * MiB, WS_TOT = 1267 * MiB, WS_FL = 1271 * MiB, WS_CUM = WS_FL + 512 * 1024, WS_D2 = 1272 * MiB, WS_END = 1304 * MiB;
constexpr size_t WS_PROJ = WS_HFF;
constexpr size_t WS_HS = WS_Y, WS_AP = WS_Y + 64 * MiB;
constexpr size_t WS_WQB = 835 * MiB, WS_WKVT = 867 * MiB, WS_WOT = 931 * MiB, WS_KVALL = 963 * MiB, WS_MEMB = 995 * MiB;
static_assert(WS_MEMB + (size_t)MROWS * DM * 2 <= WS_CAT, "prologue buffers inside HFF region");
constexpr int CW_TMO = 0, CW_BAR = 4096, CW_Q = 8192;

constexpr int RING_BYTES = 131072, LDSCTL_OFF = RING_BYTES, MISC_OFF = LDSCTL_OFF + 320, LDS_BYTES = 147456;

__device__ __forceinline__ unsigned cvt_pk_bf16(float lo, float hi) { unsigned r; asm volatile("v_cvt_pk_bf16_f32 %0, %1, %2" : "=v"(r) : "v"(lo), "v"(hi)); return r; }
__device__ __forceinline__ float bflo(unsigned u) { return __uint_as_float(u << 16); }
__device__ __forceinline__ float bfhi(unsigned u) { return __uint_as_float(u & 0xffff0000u); }
__device__ __forceinline__ float shx(float v, int m, int lane) { return __uint_as_float((unsigned)__builtin_amdgcn_ds_bpermute((lane ^ m) << 2, (int)__float_as_uint(v))); }
__device__ __forceinline__ float wave_sum(float v, int lane) {
#pragma unroll
    for (int o = 1; o < 64; o <<= 1) v += shx(v, o, lane);
    return v;
}
__device__ __forceinline__ float sigmoidf_(float x) { return __builtin_amdgcn_rcpf(1.f + __builtin_amdgcn_exp2f(-1.4426950408889634f * x)); }
__device__ __forceinline__ float gelu_tanh(float x) { const float u = 0.7978845608028654f * (x + 0.044715f * x * x * x); return x * sigmoidf_(2.f * u); }
__device__ __forceinline__ float log1p_small(float e) { const float ser = e * (1.f - e * (0.5f - e * (1.f / 3.f))); const float lg = __builtin_amdgcn_logf(1.f + e) * 0.6931471805599453f; return e < 0.01f ? ser : lg; }
__device__ __forceinline__ float fast_exp(float x) { return __builtin_amdgcn_exp2f(x * 1.4426950408889634f); }
__device__ __forceinline__ int crow(int r, int hi) { return (r & 3) + 8 * (r >> 2) + 4 * hi; }
#define LDS_WAIT() asm volatile("s_waitcnt lgkmcnt(0)" ::: "memory")
#define VM_WAIT() asm volatile("s_waitcnt vmcnt(0)" ::: "memory")

namespace pg8 {
constexpr int BM = 256, BK = 64, HALF = 128, HTB = HALF * BK * 2, STAGE_BYTES = 8 * HTB, NXCD = 8, WGM = 4;
__host__ __device__ __forceinline__ int lds_byte(int r, int c) { return (r >> 3) * 1024 + (r & 7) * 128 + ((((c >> 3) ^ (r >> 1)) & 7) * 16) + (c & 7) * 2; }
__host__ __device__ __forceinline__ void stage_rc(int b, int& R, int& C) { const int piece = b / 1024, sb = b % 1024, rr = sb / 128, pos = (sb % 128) / 16; R = piece * 8 + rr; C = ((pos ^ (R >> 1)) & 7) * 8; }
__host__ __device__ __forceinline__ int perm32(int rho) { const int n = rho >> 4, i = rho & 15; return 8 * (i >> 2) + 4 * n + (i & 3); }

struct Unit { int pm, pn; const char* a; const char* b; size_t ooff; };
struct Gemm { int lda, ldb, K; };

struct Ord {
    const char* A; const char* B; size_t a_tile, b_tile, b_batch; int nM, nN, G, c, ldc, ocols;
    __device__ __forceinline__ bool next(int i, Unit& u) const {
        const int nwg = nM * nN; const long L = (long)i * G + c; if (L >= nwg) return false;
        int wgid = (int)L; { const int q = nwg / NXCD, r = nwg % NXCD, xcd = wgid % NXCD, off = wgid / NXCD; wgid = (xcd < r ? xcd * (q + 1) : r * (q + 1) + (xcd - r) * q) + off; }
        const int nig = WGM * nN, gid = wgid / nig, fm = gid * WGM, gsz = (nM - fm) < WGM ? (nM - fm) : WGM;
        u.pm = fm + ((wgid % nig) % gsz); u.pn = (wgid % nig) / gsz;
        u.a = A + (size_t)u.pm * a_tile; u.b = B + (size_t)u.pn * b_tile + (size_t)(u.pm >> 4) * b_batch;
        u.ooff = (size_t)u.pm * 256 * ldc + (size_t)u.pn * ocols; return true;
    }
};
struct OrdG {
    const char* KV; const char* WQ; int G, c;
    __device__ __forceinline__ bool next(int i, Unit& u) const {
        const long L = (long)i * G + c; if (L >= 512) return false;
        const int z = (int)L >> 3, pn = (int)L & 7, l = z >> 4, b = (z >> 2) & 3, h = z & 3;
        u.pm = 0; u.pn = pn;
        u.a = KV + ((size_t)(b * 256) * 16384 + l * 4096 + h * 512) * 2;
        u.b = WQ + ((size_t)l * DM * DM + (size_t)(pn * 256) * DM + h * 512) * 2;
        u.ooff = ((size_t)(l * 4 + b) * 1024 + h * 256) * DM + pn * 256; return true;
    }
};
struct OrdU {
    const char* KV; const char* WOT; int G, c;
    __device__ __forceinline__ bool next(int i, Unit& u) const {
        const long L = (long)i * G + c; if (L >= 512) return false;
        const int z = (int)L >> 3, pm = (int)L & 7, l = z >> 4, b = (z >> 2) & 3, h = z & 3;
        u.pm = pm; u.pn = 0;
        u.a = WOT + ((size_t)l * DM * DM + (size_t)(pm * 256) * DM + h * 512) * 2;
        u.b = KV + ((size_t)(b * 256) * 16384 + l * 4096 + 2048 + h * 512) * 2;
        u.ooff = ((size_t)(l * 4 + b) * DM + pm * 256) * 1024 + h * 256; return true;
    }
};

struct EpiBf16 {
    static constexpr bool PERM = true, AFTER_DRAIN = false;
    bf16* O; int ldc; float scale; const float* rs;
    __device__ __forceinline__ void operator()(const f32x4 (&acc)[2][2][4][2], const Unit& u, int wr, int wc, int fr, int fq) const {
        bf16* base = O + u.ooff + (size_t)(wr * 64 + fr) * ldc + wc * 32 + 8 * fq;
        const float* rsp = rs ? rs + u.pm * BM + wr * 64 + fr : nullptr;
        float scv[2][4];
#pragma unroll
        for (int ai = 0; ai < 2; ++ai)
#pragma unroll
            for (int m = 0; m < 4; ++m) scv[ai][m] = rsp ? scale * rsp[ai * HALF + m * 16] : scale;
#pragma unroll
        for (int ai = 0; ai < 2; ++ai)
#pragma unroll
            for (int m = 0; m < 4; ++m) { bf16* rowp = base + (size_t)(ai * HALF + m * 16) * ldc; const float sc = scv[ai][m];
#pragma unroll
                for (int bj = 0; bj < 2; ++bj) { const f32x4 v0 = acc[ai][bj][m][0] * sc, v1 = acc[ai][bj][m][1] * sc;
                    u32x4 w; w.x = cvt_pk_bf16(v0[0], v0[1]); w.y = cvt_pk_bf16(v0[2], v0[3]); w.z = cvt_pk_bf16(v1[0], v1[1]); w.w = cvt_pk_bf16(v1[2], v1[3]);
                    *(u32x4*)(rowp + bj * HALF) = w; } }
    }
};
struct EpiSwiGLU {
    static constexpr bool PERM = true, AFTER_DRAIN = false;
    bf16* O; int ldc; const float* rs;
    __device__ __forceinline__ void operator()(const f32x4 (&acc)[2][2][4][2], const Unit& u, int wr, int wc, int fr, int fq) const {
        bf16* base = O + u.ooff + (size_t)(wr * 64 + fr) * ldc + wc * 32 + 8 * fq;
        const float* rsp = rs + u.pm * BM + wr * 64 + fr;
        float scv[2][4];
#pragma unroll
        for (int ai = 0; ai < 2; ++ai)
#pragma unroll
            for (int m = 0; m < 4; ++m) scv[ai][m] = rsp[ai * HALF + m * 16];
#pragma unroll
        for (int ai = 0; ai < 2; ++ai)
#pragma unroll
            for (int m = 0; m < 4; ++m) { bf16* rowp = base + (size_t)(ai * HALF + m * 16) * ldc; float o[8]; const float sc = scv[ai][m];
#pragma unroll
                for (int n = 0; n < 2; ++n)
#pragma unroll
                    for (int e = 0; e < 4; ++e) { const float g = acc[ai][0][m][n][e] * sc, up = acc[ai][1][m][n][e] * sc; o[n * 4 + e] = g * sigmoidf_(g) * up; }
                u32x4 w; w.x = cvt_pk_bf16(o[0], o[1]); w.y = cvt_pk_bf16(o[2], o[3]); w.z = cvt_pk_bf16(o[4], o[5]); w.w = cvt_pk_bf16(o[6], o[7]);
                *(u32x4*)rowp = w; }
    }
};
struct EpiF32 {
    static constexpr bool PERM = false, AFTER_DRAIN = false;
    float* C; int ldc;
    __device__ __forceinline__ void operator()(const f32x4 (&acc)[2][2][4][2], const Unit& u, int wr, int wc, int fr, int fq) const {
        float* base = C + u.ooff + (size_t)(wr * 64 + fr) * ldc + wc * 32 + 4 * fq;
#pragma unroll
        for (int ai = 0; ai < 2; ++ai)
#pragma unroll
            for (int m = 0; m < 4; ++m) { float* rowp = base + (size_t)(ai * HALF + m * 16) * ldc;
#pragma unroll
                for (int bj = 0; bj < 2; ++bj)
#pragma unroll
                    for (int n = 0; n < 2; ++n) *(f32x4*)(rowp + bj * HALF + n * 16) = acc[ai][bj][m][n]; }
    }
};
struct EpiSoftmax {
    static constexpr bool PERM = true, AFTER_DRAIN = true;
    bf16* O; int ldc; const float* rs;
    __device__ __forceinline__ void fused(f32x4 (&acc)[2][2][4][2], const Unit& u, int wr, int wc, int fr, int fq, LAS unsigned char* lds, int wid, int lane) const {
        LAS float* P1 = (LAS float*)lds;
        LAS float* P2 = (LAS float*)(lds + 4096);
        const float* rsp = rs + u.pm * BM + wr * 64 + fr;
#pragma unroll
        for (int ai = 0; ai < 2; ++ai)
#pragma unroll
            for (int m = 0; m < 4; ++m) { float mx = -3.0e38f; const float sc = rsp[ai * HALF + m * 16];
#pragma unroll
                for (int bj = 0; bj < 2; ++bj)
#pragma unroll
                    for (int n = 0; n < 2; ++n) { acc[ai][bj][m][n] = acc[ai][bj][m][n] * sc; const f32x4 x = acc[ai][bj][m][n]; mx = fmaxf(mx, fmaxf(fmaxf(x[0], x[1]), fmaxf(x[2], x[3]))); }
                mx = fmaxf(mx, shx(mx, 16, lane)); mx = fmaxf(mx, shx(mx, 32, lane));
                if (fq == 0) P1[(ai * HALF + wr * 64 + m * 16 + fr) * 4 + wc] = mx; }
        asm volatile("s_waitcnt lgkmcnt(0)" ::: "memory"); __builtin_amdgcn_s_barrier(); asm volatile("" ::: "memory");
#pragma unroll
        for (int ai = 0; ai < 2; ++ai)
#pragma unroll
            for (int m = 0; m < 4; ++m) { const int r = ai * HALF + wr * 64 + m * 16 + fr; const f32x4 q = *(const LAS f32x4*)(P1 + r * 4);
                const float mx = fmaxf(fmaxf(q[0], q[1]), fmaxf(q[2], q[3])) * 1.4426950408889634f; float s = 0.f;
#pragma unroll
                for (int bj = 0; bj < 2; ++bj)
#pragma unroll
                    for (int n = 0; n < 2; ++n) { f32x4 x = acc[ai][bj][m][n];
#pragma unroll
                        for (int e = 0; e < 4; ++e) { x[e] = __builtin_amdgcn_exp2f(x[e] * 1.4426950408889634f - mx); s += x[e]; }
                        acc[ai][bj][m][n] = x; }
                s += shx(s, 16, lane); s += shx(s, 32, lane);
                if (fq == 0) P2[r * 4 + wc] = s; }
        asm volatile("s_waitcnt lgkmcnt(0)" ::: "memory"); __builtin_amdgcn_s_barrier(); asm volatile("" ::: "memory");
        bf16* base = O + u.ooff + (size_t)(wr * 64 + fr) * ldc + wc * 32 + 8 * fq;
#pragma unroll
        for (int ai = 0; ai < 2; ++ai)
#pragma unroll
            for (int m = 0; m < 4; ++m) { const int r = ai * HALF + wr * 64 + m * 16 + fr; const f32x4 q = *(const LAS f32x4*)(P2 + r * 4);
                const float inv = __builtin_amdgcn_rcpf((q[0] + q[1]) + (q[2] + q[3])); bf16* rowp = base + (size_t)(ai * HALF + m * 16) * ldc;
#pragma unroll
                for (int bj = 0; bj < 2; ++bj) { const f32x4 v0 = acc[ai][bj][m][0] * inv, v1 = acc[ai][bj][m][1] * inv;
                    u32x4 w; w.x = cvt_pk_bf16(v0[0], v0[1]); w.y = cvt_pk_bf16(v0[2], v0[3]); w.z = cvt_pk_bf16(v1[0], v1[1]); w.w = cvt_pk_bf16(v1[2], v1[3]);
                    *(u32x4*)(rowp + bj * HALF) = w; } }
        asm volatile("s_waitcnt lgkmcnt(0)" ::: "memory"); __builtin_amdgcn_s_barrier(); asm volatile("" ::: "memory");
    }
};

template <class Epi, class Sched, bool ALIGN_EPI>
__device__ __forceinline__ void gemm_phase(LAS unsigned char* lds, const Gemm g, const Sched& S, const Epi& E) {
    int tid = threadIdx.x; asm volatile("" : "+v"(tid));
    const int wid = __builtin_amdgcn_readfirstlane(tid >> 6), lane = tid & 63, wr = wid >> 2, wc = wid & 3, fr = lane & 15, fq = lane >> 4;
    const int K = g.K, nt = K / BK;
    unsigned voffA[2], voffB[2];
#pragma unroll
    for (int i = 0; i < 2; ++i) { int R, C; stage_rc(tid * 16 + i * 8192, R, C); const int Rb = Epi::PERM ? ((R & ~31) + perm32(R & 31)) : R;
        voffA[i] = (unsigned)(R * g.lda + C) * 2u; voffB[i] = (unsigned)(Rb * g.ldb + C) * 2u; }
    const size_t kstep = (size_t)(BK * 2);
    const size_t hA = (size_t)HALF * g.lda * 2, hB = (size_t)HALF * g.ldb * 2;
    const unsigned ldsw = (unsigned)wid * 1024u;
    const int aoff = lds_byte(wr * 64 + fr, fq * 8), boff = lds_byte(wc * 32 + fr, fq * 8);
#define PG8_SA(b, h) (((b) * 2 + (h)) * HTB)
#define PG8_SB(b, h) ((4 + (b) * 2 + (h)) * HTB)
#define PG8_STAGE(bufoff, gbase, voff) do { _Pragma("unroll") for (int _i = 0; _i < 2; ++_i) \
        __builtin_amdgcn_global_load_lds((const unsigned*)((const char*)(gbase) + (voff)[_i]), (LAS unsigned*)(lds + (bufoff) + ldsw + _i * 8192), 16, 0, 0); } while (0)
#define PG8_LDA(dst, b, h) do { _Pragma("unroll") for (int m = 0; m < 4; ++m) _Pragma("unroll") for (int k = 0; k < 2; ++k) dst[m][k] = *(const LAS bf16x8*)(lds + PG8_SA(b, h) + (aoff ^ (k * 64)) + m * 2048); } while (0)
#define PG8_LDB(dst, b, h) do { _Pragma("unroll") for (int n = 0; n < 2; ++n) _Pragma("unroll") for (int k = 0; k < 2; ++k) dst[n][k] = *(const LAS bf16x8*)(lds + PG8_SB(b, h) + (boff ^ (k * 64)) + n * 2048); } while (0)
#define PG8_MMA(ai, bj, At, Bt) do { __builtin_amdgcn_s_setprio(1); _Pragma("unroll") for (int m = 0; m < 4; ++m) _Pragma("unroll") for (int n = 0; n < 2; ++n) _Pragma("unroll") for (int k = 0; k < 2; ++k) \
        acc[ai][bj][m][n] = __builtin_amdgcn_mfma_f32_16x16x32_bf16(Bt[n][k], At[m][k], acc[ai][bj][m][n], 0, 0, 0); __builtin_amdgcn_s_setprio(0); } while (0)
#define PG8_WAIT_V(n) asm volatile("s_waitcnt vmcnt(" #n ")" ::: "memory")
#define PG8_WAIT_L(n) asm volatile("s_waitcnt lgkmcnt(" #n ")" ::: "memory")
#define PG8_BAR __builtin_amdgcn_s_barrier()
#define PG8_SCHED __builtin_amdgcn_sched_barrier(0)
    Unit cur, nxt; int ui = 0;
    if (!S.next(0, cur)) return;
    f32x4 acc[2][2][4][2];
#pragma unroll
    for (int a = 0; a < 2; ++a)
#pragma unroll
        for (int b = 0; b < 2; ++b)
#pragma unroll
            for (int m = 0; m < 4; ++m)
#pragma unroll
                for (int n = 0; n < 2; ++n) acc[a][b][m][n] = (f32x4){0.f, 0.f, 0.f, 0.f};
    bf16x8 At[4][2], B0[2][2], B1[2][2];
    const char* cA = cur.a; const char* cB = cur.b;
    PG8_STAGE(PG8_SB(0, 0), cB, voffB); PG8_STAGE(PG8_SB(0, 1), cB + hB, voffB); PG8_STAGE(PG8_SA(0, 0), cA, voffA); PG8_STAGE(PG8_SA(0, 1), cA + hA, voffA);
    if (wr == 1) PG8_BAR;
    PG8_WAIT_V(2); PG8_BAR;
    PG8_STAGE(PG8_SB(1, 0), cB + kstep, voffB); PG8_STAGE(PG8_SA(1, 0), cA + kstep, voffA); PG8_STAGE(PG8_SB(1, 1), cB + hB + kstep, voffB);
    PG8_WAIT_V(6); PG8_BAR;
    for (;;) {
        const bool has_next = S.next(ui + 1, nxt);
        const char* nA = has_next ? nxt.a : cA; const char* nB = has_next ? nxt.b : cB;
        for (int t = 0; t < nt; t += 2) {
            const bool last = (t == nt - 2);
            const char* a1 = cA + (size_t)(t + 1) * kstep;
            const char* a2 = last ? nA : cA + (size_t)(t + 2) * kstep; const char* b2 = last ? nB : cB + (size_t)(t + 2) * kstep;
            const char* a3 = a2 + kstep; const char* b3 = b2 + kstep;
            PG8_LDB(B0, 0, 0); PG8_LDB(B1, 0, 1); PG8_SCHED; PG8_LDA(At, 0, 0); PG8_STAGE(PG8_SA(1, 1), a1 + hA, voffA);
            PG8_WAIT_V(8); PG8_WAIT_L(0); PG8_BAR; PG8_MMA(0, 0, At, B0); PG8_MMA(0, 1, At, B1); PG8_BAR; PG8_SCHED;
            PG8_LDA(At, 0, 1); PG8_STAGE(PG8_SB(0, 0), b2, voffB); PG8_STAGE(PG8_SB(0, 1), b2 + hB, voffB); PG8_STAGE(PG8_SA(0, 0), a2, voffA);
            PG8_WAIT_V(8); PG8_WAIT_L(0); PG8_BAR; PG8_MMA(1, 0, At, B0); PG8_MMA(1, 1, At, B1); PG8_BAR; PG8_SCHED;
            PG8_LDB(B0, 1, 0); PG8_LDB(B1, 1, 1); PG8_SCHED; PG8_LDA(At, 1, 0); PG8_STAGE(PG8_SA(0, 1), a2 + hA, voffA);
            PG8_WAIT_V(8); PG8_WAIT_L(0); PG8_BAR; PG8_MMA(0, 0, At, B0); PG8_MMA(0, 1, At, B1); PG8_BAR; PG8_SCHED;
            PG8_LDA(At, 1, 1); PG8_STAGE(PG8_SB(1, 0), b3, voffB); PG8_STAGE(PG8_SB(1, 1), b3 + hB, voffB); PG8_STAGE(PG8_SA(1, 0), a3, voffA);
            PG8_WAIT_V(8); PG8_WAIT_L(0); PG8_BAR; PG8_MMA(1, 0, At, B0); PG8_MMA(1, 1, At, B1); PG8_BAR; PG8_SCHED;
        }
        if constexpr (ALIGN_EPI) { if (wr == 0) PG8_BAR; }
        if constexpr (!Epi::AFTER_DRAIN) { E(acc, cur, wr, wc, fr, fq); }
        if (!has_next) break;
#pragma unroll
        for (int a = 0; a < 2; ++a)
#pragma unroll
            for (int b = 0; b < 2; ++b)
#pragma unroll
                for (int m = 0; m < 4; ++m)
#pragma unroll
                    for (int n = 0; n < 2; ++n) acc[a][b][m][n] = (f32x4){0.f, 0.f, 0.f, 0.f};
        cur = nxt; cA = nA; cB = nB; ++ui;
        if constexpr (ALIGN_EPI) { if (wr == 1) PG8_BAR; }
    }
    PG8_WAIT_V(0);
    if constexpr (!ALIGN_EPI) { if (wr == 0) PG8_BAR; }
    PG8_BAR;
    if constexpr (Epi::AFTER_DRAIN) { E.fused(acc, cur, wr, wc, fr, fq, lds, wid, lane); }
#undef PG8_SA
#undef PG8_SB
#undef PG8_STAGE
#undef PG8_LDA
#undef PG8_LDB
#undef PG8_MMA
#undef PG8_WAIT_V
#undef PG8_WAIT_L
#undef PG8_BAR
#undef PG8_SCHED
}
}

namespace att {
constexpr int NW = 8, QBLK = 32, KVBLK = 64, QB = NW * QBLK, D = 128, LDP = DINP;
constexpr int SHM_V = KVBLK * D * 2, SHM_K = KVBLK * D * 2;
constexpr int OFF_WS = 2 * SHM_V + 2 * SHM_K, OFF_CUM = OFF_WS + NW * 64 * 4, OFF_T5 = OFF_CUM + 16384, OFF_OST = 90112, ATT_LDS = OFF_OST + NW * 4096;
constexpr float THR = 8.f;
#define KSWZ(row, colB) ((row) * 256 + ((colB) ^ (((row) & 7) << 4)))
#define SBAR() __builtin_amdgcn_sched_barrier(0)
__device__ __forceinline__ int v_st(int k, int c) { const int kk = (k & ~0xC) | ((k & 4) << 1) | ((k & 8) >> 1); return ((kk >> 3) * 4 + (c >> 5)) * 512 + ((kk & 7) * 32 + (c & 31)) * 2; }
__device__ __forceinline__ int v_rd_base(int lane) { return ((lane & 3) << 3) | (((lane >> 2) & 3) << 6) | (((lane >> 4) & 1) << 5) | (((lane >> 5) & 1) << 8); }
constexpr int v_rd_off(int d0, int ks, int half) { return d0 * 512 + ks * 4096 + half * 2048; }
__device__ __forceinline__ bf16x8 load8(const bf16* p) { return *reinterpret_cast<const bf16x8*>(p); }

__device__ __forceinline__ void mask_causal(f32x16& p0, f32x16& p1, int dq) {
    const float NEG = -__builtin_inff();
#pragma unroll
    for (int r = 0; r < 16; ++r) { const int c = (r & 3) + 8 * (r >> 2);
        if (dq - c < 0) p0[r] = NEG;
        if (dq - c - 32 < 0) p1[r] = NEG; }
}
__device__ __forceinline__ void bias_t5(f32x16& p0, f32x16& p1, int relbase, const float* tb) {
#pragma unroll
    for (int r = 0; r < 16; ++r) { const int c = (r & 3) + 8 * (r >> 2);
        int i0 = relbase + c; i0 = (i0 < -128 ? -128 : i0) + 128; int i1 = relbase + c + 32; i1 = (i1 < -128 ? -128 : i1) + 128;
        p0[r] += tb[i0]; p1[r] += tb[i1]; }
}
template <int MODE>
__device__ __forceinline__ void partialSM(f32x16& p0, f32x16& p1, float& m_reg, float& mn, float& alpha) {
    constexpr float SCALE = MODE == 0 ? SCALE_FOX : SCALE_DIFF;
    float pmax = p0[0];
#pragma unroll
    for (int r = 1; r < 16; ++r) pmax = fmaxf(pmax, p0[r]);
#pragma unroll
    for (int r = 0; r < 16; ++r) pmax = fmaxf(pmax, p1[r]);
    { auto rr = __builtin_amdgcn_permlane32_swap(__float_as_uint(pmax), __float_as_uint(pmax), false, false);
      pmax = fmaxf(__uint_as_float(rr[0]), __uint_as_float(rr[1])); }
    constexpr float C2 = 1.4426950408889634f * SCALE;
    if (__builtin_expect(__all((pmax - m_reg) * SCALE <= THR), 1)) { mn = m_reg; alpha = 1.f; }
    else { mn = fmaxf(m_reg, pmax); alpha = __builtin_amdgcn_exp2f((m_reg - mn) * C2); m_reg = mn; }
    const float mnL = -mn * C2;
#pragma unroll
    for (int r = 0; r < 16; ++r) p0[r] = fmaf(p0[r], C2, mnL);
#pragma unroll
    for (int r = 0; r < 16; ++r) p1[r] = fmaf(p1[r], C2, mnL);
#pragma unroll
    for (int r = 0; r < 16; ++r) p0[r] = __builtin_amdgcn_exp2f(p0[r]);
}
__device__ __forceinline__ void finishSM(f32x16& p0, f32x16& p1, float alpha, float& l_reg, bf16x8& pa0, bf16x8& pa1, bf16x8& pa2, bf16x8& pa3) {
#pragma unroll
    for (int r = 0; r < 16; ++r) p1[r] = __builtin_amdgcn_exp2f(p1[r]);
    float ps = 0;
#pragma unroll
    for (int r = 0; r < 16; ++r) ps += p0[r];
#pragma unroll
    for (int r = 0; r < 16; ++r) ps += p1[r];
    { auto rr = __builtin_amdgcn_permlane32_swap(__float_as_uint(ps), __float_as_uint(ps), false, false);
      ps = __uint_as_float(rr[0]) + __uint_as_float(rr[1]); }
    l_reg = l_reg * alpha + ps;
#define PK4(P, B_, OUT) do { unsigned a0 = cvt_pk_bf16(P[B_+0], P[B_+1]), a1 = cvt_pk_bf16(P[B_+2], P[B_+3]);                          \
        unsigned b0 = cvt_pk_bf16(P[B_+4], P[B_+5]), b1 = cvt_pk_bf16(P[B_+6], P[B_+7]);                                             \
        auto r0 = __builtin_amdgcn_permlane32_swap(a0, b0, false, false); auto r1 = __builtin_amdgcn_permlane32_swap(a1, b1, false, false); \
        u32x4 w = {r0[0], r1[0], r0[1], r1[1]}; OUT = *reinterpret_cast<bf16x8*>(&w); } while (0)
    PK4(p0, 0, pa0); PK4(p0, 8, pa1); PK4(p1, 0, pa2); PK4(p1, 8, pa3);
#undef PK4
}
template <int MODE, int KB>
__device__ __forceinline__ void qkt(f32x16& p0, f32x16& p1, const char* K_lds, int kcb, int r32, int hi, const bf16x8* qr, bool act, const float* cumk, float bq) {
    constexpr int ND0 = MODE == 0 ? 8 : 4;
    if (MODE == 1 && !act) { const float NEG = -__builtin_inff();
#pragma unroll
        for (int r = 0; r < 16; ++r) { p0[r] = NEG; p1[r] = NEG; } return; }
    if constexpr (MODE == 0) {
#pragma unroll
        for (int q = 0; q < 4; ++q) { const f32x4 c0 = *(const f32x4*)(cumk + 8 * q), c1 = *(const f32x4*)(cumk + 32 + 8 * q);
#pragma unroll
            for (int e = 0; e < 4; ++e) { p0[4 * q + e] = bq - c0[e]; p1[4 * q + e] = bq - c1[e]; } }
    } else { p0 = f32x16{}; p1 = f32x16{}; }
    const char* kb[4];
#pragma unroll
    for (int dd = 0; dd < 4; ++dd) kb[dd] = K_lds + KB * SHM_K + kcb + KSWZ(r32, (dd * 16 + hi * 8) * 2);
#pragma unroll
    for (int d0 = 0; d0 < ND0; ++d0) { const char* a = kb[d0 & 3] + (d0 >> 2) * 128;
        bf16x8 b0 = *reinterpret_cast<const bf16x8*>(a);
        bf16x8 b1 = *reinterpret_cast<const bf16x8*>(a + 32 * 256);
        p0 = __builtin_amdgcn_mfma_f32_32x32x16_bf16(b0, qr[d0], p0, 0, 0, 0);
        p1 = __builtin_amdgcn_mfma_f32_32x32x16_bf16(b1, qr[d0], p1, 0, 0, 0); }
}
template <int MODE, int VB>
__device__ __forceinline__ void pv_tile(f32x16* o, int vb0, bf16x8 pa0, bf16x8 pa1, bf16x8 pa2, bf16x8 pa3, bool act) {
    if (MODE == 1 && !act) return;
#define TRRD(dst, off) asm volatile("ds_read_b64_tr_b16 %0, %1 offset:%2" : "=&v"(dst) : "v"(vb0), "i"(off) : "memory")
#define PV_D0(d0) do { s16x4 l0, l1, l2, l3, h0, h1, h2, h3; constexpr int b_ = VB * SHM_V + v_rd_off(d0, 0, 0); \
        TRRD(l0, b_); TRRD(h0, b_ + 2048); TRRD(l1, b_ + 4096); TRRD(h1, b_ + 6144); TRRD(l2, b_ + 8192); TRRD(h2, b_ + 10240); TRRD(l3, b_ + 12288); TRRD(h3, b_ + 14336); \
        asm volatile("s_waitcnt lgkmcnt(0)" ::: "memory"); SBAR();   \
        o[d0] = __builtin_amdgcn_mfma_f32_32x32x16_bf16(pa0, (bf16x8){l0[0], l0[1], l0[2], l0[3], h0[0], h0[1], h0[2], h0[3]}, o[d0], 0, 0, 0);   \
        o[d0] = __builtin_amdgcn_mfma_f32_32x32x16_bf16(pa1, (bf16x8){l1[0], l1[1], l1[2], l1[3], h1[0], h1[1], h1[2], h1[3]}, o[d0], 0, 0, 0);   \
        o[d0] = __builtin_amdgcn_mfma_f32_32x32x16_bf16(pa2, (bf16x8){l2[0], l2[1], l2[2], l2[3], h2[0], h2[1], h2[2], h2[3]}, o[d0], 0, 0, 0);   \
        o[d0] = __builtin_amdgcn_mfma_f32_32x32x16_bf16(pa3, (bf16x8){l3[0], l3[1], l3[2], l3[3], h3[0], h3[1], h3[2], h3[3]}, o[d0], 0, 0, 0); } while (0)
    PV_D0(0); PV_D0(1); PV_D0(2); PV_D0(3);
#undef PV_D0
#undef TRRD
}

struct Blk { const bf16* Q; const bf16* K; const bf16* V; int P0; int kcb; int bh; };
struct Seam { bf16x8 qr[8]; bf16x8 st_v0, st_v1, st_k0, st_k1; };
struct EpiCtx { bf16* out; int ld; };
#define ROW(p, k0, rr) ((p) + (size_t)((k0) + (rr)) * LDP + sc)
#define VMW() asm volatile("s_waitcnt vmcnt(0)" ::: "memory")
#define VMWN(n) asm volatile("s_waitcnt vmcnt(%0)" :: "i"(n) : "memory")
#define SLOAD_H(Kp, Vp, k0) do { S.st_v0 = load8(ROW(Vp, k0, sr)); S.st_v1 = load8(ROW(Vp, k0, 32 + sr));              \
                         S.st_k0 = load8(ROW(Kp, k0, sr)); S.st_k1 = load8(ROW(Kp, k0, 32 + sr)); } while (0)
#define SWRITE_HK(bf) do { *(bf16x8*)(K_lds + (bf) * SHM_K + kws) = S.st_k0; *(bf16x8*)(K_lds + (bf) * SHM_K + kws + 32 * 256) = S.st_k1; } while (0)
#define SWRITE_HV(bf) do { *(bf16x8*)(V_lds + (bf) * SHM_V + vst0) = S.st_v0; *(bf16x8*)(V_lds + (bf) * SHM_V + vst1) = S.st_v1; } while (0)
#define SWRITE_H(bf) do { SWRITE_HV(bf); SWRITE_HK(bf); } while (0)
template <int MODE>
__device__ __forceinline__ void attn_prime(const Blk& cur, char* lds, Seam& S) {
    constexpr int ND0 = 8;
    int tid = threadIdx.x; asm volatile("" : "+v"(tid));
    const int wid = __builtin_amdgcn_readfirstlane(tid >> 6), lane = tid & 63, r32 = lane & 31, hi = lane >> 5;
    const int sr = tid >> 4, sc = (tid & 15) * 8, kws = KSWZ(sr, sc * 2); char* K_lds = lds + 2 * SHM_V;
#pragma unroll
    for (int d0 = 0; d0 < ND0; ++d0) S.qr[d0] = load8(cur.Q + (size_t)(wid * QBLK + r32) * LDP + d0 * 16 + hi * 8);
    SLOAD_H(cur.K, cur.V, 0); VMW(); SWRITE_HK(0);
    __syncthreads();
}
template <int MODE>
__device__ __forceinline__ void attn_block(const Blk& cur, const Blk& nxt, char* lds, Seam& S, const EpiCtx& E, const float* aux) {
    constexpr int ND0 = 8;
    int tid = threadIdx.x; asm volatile("" : "+v"(tid));
    const int wid = __builtin_amdgcn_readfirstlane(tid >> 6), lane = tid & 63, r32 = lane & 31, hi = lane >> 5;
    const int NT = cur.P0 / KVBLK + 4;
    const int qlo = cur.P0 + wid * QBLK, qm = qlo + r32 - 4 * hi;
    char* V_lds = lds; char* K_lds = lds + 2 * SHM_V;
    float* ws = (float*)(lds + OFF_WS) + wid * 64; float* li_l = ws, * al_l = ws + 32;
    float m_reg = -1e30f, l_reg = 0; f32x16 o[4] = {};
    const int sr = tid >> 4, sc = (tid & 15) * 8, vst0 = v_st(sr, sc), vst1 = v_st(32 + sr, sc), kws = KSWZ(sr, sc * 2);
    const int vb0 = (int)(uintptr_t)V_lds + v_rd_base(lane);
    const bf16* Kh = cur.K; const bf16* Vh = cur.V;
    const int kcb = cur.kcb;
    float bq = 0.f; if (MODE == 0) bq = aux[qlo + r32];
    const float* cumk0 = aux + 4 * hi;
#define RESC(a) do { if (__any((a) < 1.f)) { if (hi == 0) al_l[r32] = (a); asm volatile("s_waitcnt lgkmcnt(0)" ::: "memory");              \
                     for (int d_ = 0; d_ < 4; ++d_) for (int r = 0; r < 16; ++r) o[d_][r] *= al_l[crow(r, hi)]; } } while (0)
#define KBASE(t) ((t) * KVBLK)
#define ACT(t) (MODE == 0 ? true : (KBASE(t) <= (qlo & ~63)))
#define MASKT(P0_, P1_, t) do { const int kb_ = KBASE(t); \
        if (MODE == 0) { if (kb_ + KVBLK - 1 > qlo) mask_causal(P0_, P1_, qm - kb_); } \
        else { if (ACT(t) && kb_ + 191 > qlo) bias_t5(P0_, P1_, kb_ + 4 * hi - (qlo + r32), aux); } } while (0)
#define SEAM_K0() do { VMWN(ND0); SWRITE_HK(0); SBAR(); } while (0)
    f32x16 pA0, pA1, pB0, pB1; float mnA, mnB, alA, alB; bf16x8 pa0, pa1, pa2, pa3;
    SWRITE_HV(0); SBAR();
    SLOAD_H(Kh, Vh, KBASE(1));
    SBAR(); qkt<MODE, 0>(pA0, pA1, K_lds, kcb, r32, hi, S.qr, ACT(0), cumk0 + KBASE(0), bq);
    MASKT(pA0, pA1, 0); partialSM<MODE>(pA0, pA1, m_reg, mnA, alA);
    VMW(); SWRITE_H(1);
    __syncthreads();
#define HALF_STEP(PX0, PX1, mnX, alX, PY0, PY1, alY, t, KB, VB, SB) do {                                                      \
        SBAR(); qkt<MODE, KB>(PX0, PX1, K_lds, kcb, r32, hi, S.qr, ACT(t), cumk0 + KBASE(t), bq);                            \
        finishSM(PY0, PY1, alY, l_reg, pa0, pa1, pa2, pa3); SBAR();                                                           \
        if ((t) + 1 < NT) { SLOAD_H(Kh, Vh, KBASE((t) + 1)); SBAR(); }                                                        \
        pv_tile<MODE, VB>(o, vb0, pa0, pa1, pa2, pa3, ACT((t) - 1)); MASKT(PX0, PX1, (t)); partialSM<MODE>(PX0, PX1, m_reg, mnX, alX);   \
        __syncthreads();                                                                                                      \
        if ((t) + 1 < NT) { VMW(); SWRITE_H(SB); }                                                                            \
        RESC(alX); __syncthreads(); } while (0)
    for (int t = 1; t + 1 < NT; t += 2) {
        HALF_STEP(pB0, pB1, mnB, alB, pA0, pA1, alA, t, 1, 0, 0);
        HALF_STEP(pA0, pA1, mnA, alA, pB0, pB1, alB, t + 1, 0, 1, 1);
    }
    SBAR(); qkt<MODE, 1>(pB0, pB1, K_lds, kcb, r32, hi, S.qr, ACT(NT - 1), cumk0 + KBASE(NT - 1), bq); SBAR();
    SLOAD_H(nxt.K, nxt.V, 0); SBAR();
#pragma unroll
    for (int d0 = 0; d0 < ND0; ++d0) S.qr[d0] = load8(nxt.Q + (size_t)(wid * QBLK + r32) * LDP + d0 * 16 + hi * 8);
    SBAR();
    finishSM(pA0, pA1, alA, l_reg, pa0, pa1, pa2, pa3); SBAR();
    pv_tile<MODE, 0>(o, vb0, pa0, pa1, pa2, pa3, ACT(NT - 2));
    MASKT(pB0, pB1, NT - 1); partialSM<MODE>(pB0, pB1, m_reg, mnB, alB); __syncthreads(); RESC(alB);
    finishSM(pB0, pB1, alB, l_reg, pa0, pa1, pa2, pa3); SBAR(); pv_tile<MODE, 1>(o, vb0, pa0, pa1, pa2, pa3, ACT(NT - 1));
    SBAR(); SEAM_K0();
    if (hi == 0) li_l[r32] = l_reg; asm volatile("s_waitcnt lgkmcnt(0)" ::: "memory");
    float rli[16];
#pragma unroll
    for (int r = 0; r < 16; ++r) rli[r] = __builtin_amdgcn_rcpf(li_l[crow(r, hi)]);
    {
        bf16* Ow = E.out + (size_t)(wid * QBLK) * E.ld;
        bf16* stg = (bf16*)(lds + OFF_OST) + wid * 2048;
#pragma unroll
        for (int half = 0; half < 2; ++half) {
#pragma unroll
            for (int r = 0; r < 16; ++r) { const int orow = crow(r, hi);
#pragma unroll
                for (int dd = 0; dd < 2; ++dd) stg[orow * 64 + dd * 32 + r32] = (bf16)(cvt_pk_bf16(o[2 * half + dd][r] * rli[r], 0.f) & 0xffffu); }
            asm volatile("s_waitcnt lgkmcnt(0)" ::: "memory");
#pragma unroll
            for (int i = 0; i < 4; ++i) { const int row = i * 8 + (lane >> 3), ch = lane & 7;
                const u32x4 v = *(const u32x4*)(stg + row * 64 + ch * 8);
                *(u32x4*)(Ow + (size_t)row * E.ld + half * 64 + ch * 8) = v; }
            asm volatile("s_waitcnt lgkmcnt(0)" ::: "memory");
        }
    }
    __syncthreads();
#undef RESC
#undef KBASE
#undef ACT
#undef MASKT
#undef SEAM_K0
#undef HALF_STEP
}
#undef ROW
#undef VMW
#undef VMWN
#undef SLOAD_H
#undef SWRITE_HK
#undef SWRITE_HV
#undef SWRITE_H
}

#define XB_TMO      128
#define XB_XCNT(j)  (256  + 64 * (j))
#define XB_XSUB(j)  (1280 + 64 * (j))
#define XB_XGEN(j)  (2304 + 64 * (j))
#define XB_TOP      3328
#define XB_TOPGEN   3392
#define XCD_BAR_WORDS 3456
#define XB_SPIN_CAP (1u << 18)
__device__ __forceinline__ unsigned xb_ld(unsigned* p)              { return __hip_atomic_load(p, __ATOMIC_RELAXED, __HIP_MEMORY_SCOPE_AGENT); }
__device__ __forceinline__ unsigned xb_add(unsigned* p, unsigned v) { return __hip_atomic_fetch_add(p, v, __ATOMIC_RELAXED, __HIP_MEMORY_SCOPE_AGENT); }
__device__ __forceinline__ unsigned xb_xcc_id() { return (unsigned)__builtin_amdgcn_s_getreg((3 << 11) | 20) & 0xFu; }
#define XB_SPIN(cond, bar) do { unsigned _sp = 0; while (cond) { __builtin_amdgcn_s_sleep(1); \
    if ((++_sp & 255u) == 0u) { if (xb_ld(&(bar)[XB_TMO])) break; if (_sp > XB_SPIN_CAP) { atomicAdd(&(bar)[XB_TMO], 1u); break; } } } } while (0)
struct XcdBarrier { unsigned* bar; unsigned x; volatile LAS unsigned* st; };
__device__ __forceinline__ XcdBarrier xcd_barrier_post(unsigned* bar, volatile LAS unsigned* st) {
    XcdBarrier b; b.bar = bar; b.x = xb_xcc_id(); b.st = st;
    if (threadIdx.x == 0) (void)xb_add(&bar[XB_XCNT(b.x)], 1u);
    return b;
}
__device__ __forceinline__ void xcd_barrier_complete(unsigned* bar, unsigned x, unsigned& nloc, unsigned& nx) {
    const unsigned G = gridDim.x * gridDim.y * gridDim.z;
    unsigned sum, cnt, mine, sp = 0u;
    for (;;) {
        sum = 0u; cnt = 0u; mine = 0u;
#pragma unroll
        for (unsigned j = 0; j < 16; ++j) { const unsigned c = xb_ld(&bar[XB_XCNT(j)]); sum += c; cnt += (c > 0u) ? 1u : 0u; mine = (j == x) ? c : mine; }
        if (sum == G) break;
        __builtin_amdgcn_s_sleep(1);
        if ((++sp & 255u) == 0u) { if (xb_ld(&bar[XB_TMO])) break; if (sp > XB_SPIN_CAP) { atomicAdd(&bar[XB_TMO], 1u); break; } }
    }
    nloc = mine > 0u ? mine : 1u; nx = cnt > 0u ? cnt : 1u;
}
__device__ __forceinline__ void xcd_barrier(const XcdBarrier& b) {
    asm volatile("s_waitcnt vmcnt(0)" ::: "memory");
    __syncthreads();
    if (threadIdx.x == 0) {
        unsigned* bar = b.bar;
        __builtin_amdgcn_s_waitcnt(0);
        unsigned nloc = b.st[0], nx = b.st[1];
        if (nloc == 0u) { xcd_barrier_complete(bar, b.x, nloc, nx); b.st[0] = nloc; b.st[1] = nx; }
        const unsigned old = xb_add(&bar[XB_XSUB(b.x)], 1u);
        const unsigned gen = old / nloc;
        if (old + 1u == (gen + 1u) * nloc) {
            __builtin_amdgcn_fence(__ATOMIC_RELEASE, "agent");
            asm volatile("s_waitcnt vmcnt(0)" ::: "memory");
            const unsigned og = xb_add(&bar[XB_TOP], 1u);
            const unsigned tg = og / nx;
            if (og + 1u == (tg + 1u) * nx) xb_add(&bar[XB_TOPGEN], 1u);
            else XB_SPIN(xb_ld(&bar[XB_TOPGEN]) == tg, bar);
            __builtin_amdgcn_fence(__ATOMIC_ACQUIRE, "agent");
            xb_add(&bar[XB_XGEN(b.x)], 1u);
            asm volatile("s_waitcnt vmcnt(0)" ::: "memory");
        } else {
            XB_SPIN(xb_ld(&bar[XB_XGEN(b.x)]) == gen, bar);
            __builtin_amdgcn_fence(__ATOMIC_ACQUIRE, "agent");
            asm volatile("s_waitcnt vmcnt(0)" ::: "memory");
        }
    }
    __syncthreads();
}

struct Ctx { LAS unsigned char* lds; int tid, lane, wave, vcu, G; };

__device__ __forceinline__ void transpose_item(const float* W, int ld, bf16* WT, int ldt, int k0, int n0, int row_base, LAS float* scr, int lane, const float* gain) {
    float t_[32];
    { const float* wp = W + (size_t)(k0 + (lane >> 5)) * ld + n0 + (lane & 31);
#pragma unroll
      for (int i = 0; i < 32; ++i) t_[i] = wp[(size_t)(2 * i) * ld];
      if (gain) { const float* gp_ = gain + k0 + (lane >> 5);
#pragma unroll
          for (int i = 0; i < 32; ++i) t_[i] *= gp_[2 * i]; } }
#pragma unroll
    for (int i = 0; i < 32; ++i) scr[(2 * i + (lane >> 5)) * 33 + (lane & 31)] = t_[i];
    LDS_WAIT(); asm volatile("" ::: "memory");
    const int c = lane & 7;
#pragma unroll
    for (int j = 0; j < 4; ++j) { const int n = (lane >> 3) + 8 * j; const LAS float* s = scr + (8 * c) * 33 + n;
        u32x4 o; o.x = cvt_pk_bf16(s[0 * 33], s[1 * 33]); o.y = cvt_pk_bf16(s[2 * 33], s[3 * 33]); o.z = cvt_pk_bf16(s[4 * 33], s[5 * 33]); o.w = cvt_pk_bf16(s[6 * 33], s[7 * 33]);
        *(u32x4*)(WT + (size_t)(row_base + n) * ldt + k0 + 8 * c) = o; }
    LDS_WAIT(); asm volatile("" ::: "memory");
}

enum { I_X = 0, I_MEM, I_NORMG, I_F1IN, I_F1OUT, I_WIN, I_CONVW, I_CONVB, I_GATEW, I_GATEB, I_LAM, I_DLAM, I_SUBG, I_FBIAS, I_RELB, I_WOUT, I_WQ, I_WKV, I_WO, I_F2IN, I_F2OUT, I_OUT, I_WS };
typedef const __attribute__((address_space(4))) unsigned long long* kaptr_t;
__device__ __forceinline__ const float* karg(int i) { kaptr_t ka = (kaptr_t)__builtin_amdgcn_kernarg_segment_ptr(); asm volatile("" : "+s"(ka)); return (const float*)(const GAS float*)ka[i]; }
__device__ __forceinline__ void prologue_convert(const Ctx& F, unsigned char* ws, const int l0, const int l1, const bool xatt) {
    LAS float* scr = (LAS float*)(F.lds + F.wave * 16384);
    const int gw = F.vcu * 8 + F.wave, NGW = F.G * 8;
    const int njob = (l1 - l0) * 6 + (xatt ? DEPTH * 2 : 0);
    for (int job = 0; job < njob; ++job) {
        int l, k; if (job < (l1 - l0) * 6) { l = l0 + job / 6; k = job - (job / 6) * 6; } else { const int j2 = job - (l1 - l0) * 6; l = j2 >> 1; k = 6 + (j2 & 1); }
        const float* src; bf16* dst; int K, N, ld, kind = 0; const float* gain = nullptr;
        switch (k) {
            case 0:  src = karg(I_F1IN) + (size_t)l * DM * 2 * DFF;  dst = (bf16*)(ws + WS_W1I) + (size_t)l * 2 * DFF * DM; K = DM; N = 2 * DFF; ld = 2 * DFF; kind = 1; gain = karg(I_NORMG) + ((size_t)l * 8 + 0) * DM; break;
            case 1:  src = karg(I_F1OUT) + (size_t)l * DFF * DM;     dst = (bf16*)(ws + WS_W1O) + (size_t)l * DM * DFF;     K = DFF; N = DM; ld = DM; break;
            case 2:  src = karg(I_F2IN) + (size_t)l * DM * 2 * DFF;  dst = (bf16*)(ws + WS_W2I) + (size_t)l * 2 * DFF * DM; K = DM; N = 2 * DFF; ld = 2 * DFF; kind = 1; gain = karg(I_NORMG) + ((size_t)l * 8 + 6) * DM; break;
            case 3:  src = karg(I_F2OUT) + (size_t)l * DFF * DM;     dst = (bf16*)(ws + WS_W2O) + (size_t)l * DM * DFF;     K = DFF; N = DM; ld = DM; break;
            case 4:  src = karg(I_WIN) + (size_t)l * DM * DIN;           dst = (bf16*)(ws + WS_WIN) + (size_t)l * DINP * DM;    K = DM; N = DINP; ld = DIN; gain = karg(I_NORMG) + ((size_t)l * 8 + 2) * DM; break;
            case 5:  src = karg(I_WOUT) + (size_t)l * DM * DM;           dst = (bf16*)(ws + WS_WOUT) + (size_t)l * DM * DM;     K = DM; N = DM; ld = DM; break;
            case 6:  src = karg(I_WKV) + (size_t)l * DM * 2 * DM;  dst = (bf16*)(ws + WS_WKVT) + (size_t)l * 2 * DM * DM; K = DM; N = 2 * DM; ld = 2 * DM; break;
            default: src = karg(I_WO) + (size_t)l * DM * DM;       dst = (bf16*)(ws + WS_WOT) + (size_t)l * DM * DM;      K = DM; N = DM; ld = DM; break;
        }
        const int nblk = N / 32, nitems = (K / 64) * nblk;
        for (int it = gw; it < nitems; it += NGW) {
            const int kb = it / nblk, nb = it - kb * nblk, n0 = 32 * nb;
            int rb = n0;
            if (kind == 1) { const int up = n0 >= DFF, nn = n0 - up * DFF; rb = (nn >> 7) * 256 + up * 128 + (nn & 127); }
            transpose_item(src, ld, dst, K, 64 * kb, n0, rb, scr, F.lane, gain);
        }
    }
    for (int it = gw + l0 * 16 * 8; it < l1 * 16 * 8; it += NGW) { const int mat = it >> 3, sub = it & 7, kb = sub >> 2, nb = sub & 3;
        transpose_item(karg(I_GATEW) + (size_t)mat * 16384, 128, (bf16*)(ws + WS_GW) + (size_t)mat * 16384, 128, 64 * kb, 32 * nb, 32 * nb, scr, F.lane, nullptr); }
    if (xatt) {
    { const size_t n8 = (size_t)DEPTH * DM * DM / 8; bf16* d = (bf16*)(ws + WS_WQB); const float* wq = karg(I_WQ); const float* ng = karg(I_NORMG);
      for (size_t i = (size_t)gw * 64 + F.lane; i < n8; i += (size_t)NGW * 64) { const f32x4 a = *(const f32x4*)(wq + i * 8), b = *(const f32x4*)(wq + i * 8 + 4);
          const size_t row = i >> 8; const int l = (int)(row >> 11), din = (int)(row & 2047); const float g4 = ng[((size_t)l * 8 + 4) * DM + din];
          u32x4 o; o.x = cvt_pk_bf16(a[0] * g4, a[1] * g4); o.y = cvt_pk_bf16(a[2] * g4, a[3] * g4); o.z = cvt_pk_bf16(b[0] * g4, b[1] * g4); o.w = cvt_pk_bf16(b[2] * g4, b[3] * g4); *(u32x4*)(d + i * 8) = o; } }
    { const size_t n8 = (size_t)MROWS * DM / 8; bf16* d = (bf16*)(ws + WS_MEMB);
      for (size_t i = (size_t)gw * 64 + F.lane; i < n8; i += (size_t)NGW * 64) { const f32x4 a = *(const f32x4*)(karg(I_MEM) + i * 8), b = *(const f32x4*)(karg(I_MEM) + i * 8 + 4);
          u32x4 o; o.x = cvt_pk_bf16(a[0], a[1]); o.y = cvt_pk_bf16(a[2], a[3]); o.z = cvt_pk_bf16(b[0], b[1]); o.w = cvt_pk_bf16(b[2], b[3]); *(u32x4*)(d + i * 8) = o; } }
    }
}

__device__ __forceinline__ void norm_phase(const Ctx& F, const float* x32, const bf16* hb_in, const bf16* y, float wgt, const float* gpost, const float* gpre, bf16* hb_out, float* rs, float* out32, const float* wfl, float* fl) {
    LAS f32x4* wl = (LAS f32x4*)F.lds;
    if (wfl) { for (int k = F.tid; k < DM; k += 512) wl[k] = *(const f32x4*)(wfl + (size_t)k * DIN); }
    __syncthreads();
    const int gw = F.vcu * 8 + F.wave, NGW = F.G * 8;
    f32x4 gp[8], gq[8];
#pragma unroll
    for (int j = 0; j < 4; ++j)
#pragma unroll
        for (int q = 0; q < 2; ++q) { const int c = 8 * F.lane + 512 * j + 4 * q;
            gp[2 * j + q] = y ? *(const f32x4*)(gpost + c) : (f32x4){0.f, 0.f, 0.f, 0.f}; gq[2 * j + q] = wfl ? *(const f32x4*)(gpre + c) : (f32x4){0.f, 0.f, 0.f, 0.f}; }
    for (int m = gw; m < M; m += NGW) {
        const size_t ro = (size_t)m * DM + 8 * F.lane;
        f32x4 h[8];
        if (x32) {
#pragma unroll
            for (int j = 0; j < 4; ++j) { h[2 * j] = *(const f32x4*)(x32 + ro + 512 * j); h[2 * j + 1] = *(const f32x4*)(x32 + ro + 512 * j + 4); }
        } else {
#pragma unroll
            for (int j = 0; j < 4; ++j) { const u32x4 w = *(const u32x4*)(hb_in + ro + 512 * j);
                h[2 * j] = (f32x4){bflo(w.x), bfhi(w.x), bflo(w.y), bfhi(w.y)}; h[2 * j + 1] = (f32x4){bflo(w.z), bfhi(w.z), bflo(w.w), bfhi(w.w)}; }
        }
        if (y) {
            f32x4 v[8]; float ss = 0.f;
#pragma unroll
            for (int j = 0; j < 4; ++j) { const u32x4 w = *(const u32x4*)(y + ro + 512 * j);
                v[2 * j] = (f32x4){bflo(w.x), bfhi(w.x), bflo(w.y), bfhi(w.y)}; v[2 * j + 1] = (f32x4){bflo(w.z), bfhi(w.z), bflo(w.w), bfhi(w.w)}; }
#pragma unroll
            for (int j = 0; j < 8; ++j) ss += (v[j][0] * v[j][0] + v[j][1] * v[j][1]) + (v[j][2] * v[j][2] + v[j][3] * v[j][3]);
            const float r = wgt * __builtin_amdgcn_rsqf(wave_sum(ss, F.lane) * (1.f / DM) + EPS);
#pragma unroll
            for (int j = 0; j < 8; ++j) h[j] = h[j] + (v[j] * r) * gp[j];
        }
        if (out32) {
#pragma unroll
            for (int j = 0; j < 4; ++j) { *(f32x4*)(out32 + ro + 512 * j) = h[2 * j]; *(f32x4*)(out32 + ro + 512 * j + 4) = h[2 * j + 1]; }
        }
        if (hb_out) {
            float ss = 0.f;
#pragma unroll
            for (int j = 0; j < 8; ++j) ss += (h[j][0] * h[j][0] + h[j][1] * h[j][1]) + (h[j][2] * h[j][2] + h[j][3] * h[j][3]);
            const float r = __builtin_amdgcn_rsqf(wave_sum(ss, F.lane) * (1.f / DM) + EPS);
            if (F.lane == 0) rs[m] = r;
            float f0 = 0.f, f1 = 0.f, f2 = 0.f, f3 = 0.f;
#pragma unroll
            for (int j = 0; j < 4; ++j) { const f32x4 h0 = h[2 * j], h1 = h[2 * j + 1];
                u32x4 w; w.x = cvt_pk_bf16(h0[0], h0[1]); w.y = cvt_pk_bf16(h0[2], h0[3]); w.z = cvt_pk_bf16(h1[0], h1[1]); w.w = cvt_pk_bf16(h1[2], h1[3]);
                *(u32x4*)(hb_out + ro + 512 * j) = w;
                if (wfl) { const f32x4 n0 = (h0 * r) * gq[2 * j], n1 = (h1 * r) * gq[2 * j + 1];
#pragma unroll
                    for (int e = 0; e < 4; ++e) { const f32x4 wa = wl[8 * F.lane + 512 * j + e], wb = wl[8 * F.lane + 512 * j + 4 + e];
                        f0 += n0[e] * wa[0] + n1[e] * wb[0]; f1 += n0[e] * wa[1] + n1[e] * wb[1]; f2 += n0[e] * wa[2] + n1[e] * wb[2]; f3 += n0[e] * wa[3] + n1[e] * wb[3]; } } }
            if (wfl) { f0 = wave_sum(f0, F.lane); f1 = wave_sum(f1, F.lane); f2 = wave_sum(f2, F.lane); f3 = wave_sum(f3, F.lane);
                if (F.lane == 0) { fl[m] = f0; fl[M + m] = f1; fl[2 * M + m] = f2; fl[3 * M + m] = f3; } }
        }
    }
}

__device__ __forceinline__ void cum_wave(const float* fl, const float* fbias, float* cum, int bh, int lane) {
    const int b = bh >> 2, h = bh & 3; const float fb = fbias[h];
    const float* f = fl + (size_t)h * M + (size_t)b * SEQ + lane * 64;
    float v[64]; float run = 0.f;
#pragma unroll
    for (int i = 0; i < 16; ++i) { const f32x4 a = *(const f32x4*)(f + 4 * i);
#pragma unroll
        for (int e = 0; e < 4; ++e) { const float z = a[e] + fb; const float ls = fminf(z, 0.f) - log1p_small(fast_exp(-fabsf(z))); run += ls; v[4 * i + e] = run; } }
    float inc = run;
#pragma unroll
    for (int o = 1; o < 64; o <<= 1) { const float t = __uint_as_float((unsigned)__builtin_amdgcn_ds_bpermute(((lane - o) & 63) << 2, (int)__float_as_uint(inc))); if (lane >= o) inc += t; }
    const float excl = inc - run;
    float* c = cum + (size_t)bh * SEQ + lane * 64;
#pragma unroll
    for (int i = 0; i < 16; ++i) { f32x4 o4;
#pragma unroll
        for (int e = 0; e < 4; ++e) o4[e] = (v[4 * i + e] + excl) * (1.f / SCALE_FOX);
        *(f32x4*)(c + 4 * i) = o4; }
}

__device__ __forceinline__ void lru_local_item(int item, LAS unsigned char* xt, LAS unsigned char* ostg, const bf16* proj, const float* convw, const float* convb, const bf16* gwt, const float* gateb,
                                               const float* lam, bf16* HS, bf16* AP, float* TOT, int lane) {
    const int n = item & 7, ch = (item >> 3) & 127, b = item >> 10;
    const int t0 = ch * 32, c0 = n * 128, r32 = lane & 31, hi = lane >> 5;
    const size_t row0 = (size_t)b * SEQ + t0;
    {
        const int c = c0 + 2 * lane;
        f32x2 w[4];
#pragma unroll
        for (int k = 0; k < 4; ++k) w[k] = *(const f32x2*)(convw + k * LRUW + c);
        const f32x2 cb = *(const f32x2*)(convb + c);
        unsigned raw[35];
#pragma unroll
        for (int i = 0; i < 35; ++i) { const int t = t0 - 3 + i; raw[i] = (t >= 0) ? *(const unsigned*)(proj + (size_t)((long)row0 - 3 + i) * DINP + C_AX + c) : 0u; }
#pragma unroll
        for (int tl = 0; tl < 32; ++tl) {
            const float x0 = cb[0] + w[0][0] * bflo(raw[tl]) + w[1][0] * bflo(raw[tl + 1]) + w[2][0] * bflo(raw[tl + 2]) + w[3][0] * bflo(raw[tl + 3]);
            const float x1 = cb[1] + w[0][1] * bfhi(raw[tl]) + w[1][1] * bfhi(raw[tl + 1]) + w[2][1] * bfhi(raw[tl + 2]) + w[3][1] * bfhi(raw[tl + 3]);
            *(LAS unsigned*)(xt + tl * 272 + lane * 4) = cvt_pk_bf16(x0, x1); }
    }
    LDS_WAIT(); asm volatile("" ::: "memory");
    f32x16 acc[2][4];
#pragma unroll
    for (int g = 0; g < 2; ++g)
#pragma unroll
        for (int j = 0; j < 4; ++j) acc[g][j] = f32x16{};
    const bf16* gb = gwt + ((size_t)n * 128 + r32) * 128 + 8 * hi;
#pragma unroll
    for (int ks = 0; ks < 8; ++ks) {
        const bf16x8 a = *(const LAS bf16x8*)(xt + r32 * 272 + ks * 32 + hi * 16);
#pragma unroll
        for (int g = 0; g < 2; ++g)
#pragma unroll
            for (int j = 0; j < 4; ++j) { const bf16x8 bfr = *(const bf16x8*)(gb + (size_t)g * 131072 + j * 4096 + ks * 16);
                acc[g][j] = __builtin_amdgcn_mfma_f32_32x32x16_bf16(a, bfr, acc[g][j], 0, 0, 0); }
    }
#pragma unroll
    for (int j = 0; j < 4; ++j) {
        const int c = c0 + 32 * j + r32;
        const float gbr = gateb[c], gbi = gateb[LRUW + c], sp = log1p_small(fast_exp(-lam[c]));
#pragma unroll
        for (int r = 0; r < 16; ++r) { const int tl = crow(r, hi);
            const float x = __uint_as_float((unsigned)(*(const LAS unsigned short*)(xt + tl * 272 + (32 * j + r32) * 2)) << 16);
            const float rs = sigmoidf_(acc[0][j][r] + gbr), is = sigmoidf_(acc[1][j][r] + gbi);
            const float a = fast_exp(-8.f * rs * sp);
            acc[0][j][r] = a; acc[1][j][r] = __builtin_amdgcn_sqrtf(fmaxf(1.f - a * a, 0.f)) * (is * x); }
        float Ag[4], Bg[4], Ao[4], Bo[4], Ain[4], Hin[4];
#pragma unroll
        for (int q = 0; q < 4; ++q) { float A = acc[0][j][4 * q], H = acc[1][j][4 * q];
#pragma unroll
            for (int e = 1; e < 4; ++e) { const float a = acc[0][j][4 * q + e]; H = a * H + acc[1][j][4 * q + e]; A = a * A; acc[0][j][4 * q + e] = A; acc[1][j][4 * q + e] = H; }
            Ag[q] = A; Bg[q] = H; }
#pragma unroll
        for (int q = 0; q < 4; ++q) { Ao[q] = shx(Ag[q], 32, lane); Bo[q] = shx(Bg[q], 32, lane); }
        float Ac = 1.f, Hc = 0.f;
#pragma unroll
        for (int q = 0; q < 4; ++q) {
            const float a0 = hi ? Ao[q] : Ag[q], b0 = hi ? Bo[q] : Bg[q], a1 = hi ? Ag[q] : Ao[q], b1 = hi ? Bg[q] : Bo[q];
            const float Ac0 = Ac, Hc0 = Hc; Hc = a0 * Hc + b0; Ac = a0 * Ac;
            const float Ac1 = Ac, Hc1 = Hc; Hc = a1 * Hc + b1; Ac = a1 * Ac;
            Ain[q] = hi ? Ac1 : Ac0; Hin[q] = hi ? Hc1 : Hc0; }
        { LAS bf16* sh = (LAS bf16*)ostg; LAS bf16* sa = sh + 1024;
#pragma unroll
          for (int r = 0; r < 16; ++r) { const int q = r >> 2; const int tl = crow(r, hi);
              sh[tl * 32 + r32] = (bf16)(cvt_pk_bf16(acc[1][j][r] + acc[0][j][r] * Hin[q], 0.f) & 0xffffu);
              sa[tl * 32 + r32] = (bf16)(cvt_pk_bf16(acc[0][j][r] * Ain[q], 0.f) & 0xffffu); }
          LDS_WAIT(); asm volatile("" ::: "memory");
#pragma unroll
          for (int i = 0; i < 2; ++i) { const int slot = i * 64 + lane, row = slot >> 2, chunk = slot & 3; const size_t o = (row0 + row) * LRUW + c0 + 32 * j + chunk * 8;
              *(u32x4*)(HS + o) = *(const LAS u32x4*)(sh + row * 32 + chunk * 8); *(u32x4*)(AP + o) = *(const LAS u32x4*)(sa + row * 32 + chunk * 8); }
          LDS_WAIT(); asm volatile("" ::: "memory"); }
        if (hi == 0) { const size_t o = ((size_t)(b * 128 + ch) * 2) * LRUW + c; TOT[o] = Ac; TOT[o + LRUW] = Hc; }
    }
    LDS_WAIT(); asm volatile("" ::: "memory");
}
__device__ __forceinline__ void lru_fix_group(int item, LAS unsigned char* lds, const bf16* proj, const bf16* HS, const bf16* AP, const float* TOT, bf16* cat, int wave, int lane,
                                              const bf16* D1, const bf16* D2, const float* subg, float lam, float nscale) {
    const size_t crow0 = ((size_t)item * 8 + wave) * 8;
    u32x4 wa[8], wb[8];
#pragma unroll
    for (int q = 0; q < 8; ++q) { const size_t o = (crow0 + q) * 512 + 8 * lane; wa[q] = *(const u32x4*)(D1 + o); wb[q] = *(const u32x4*)(D2 + o); }
    const int cg = item & 15, g = (item >> 4) & 3, b = item >> 6;
    const int c = g * 256 + 4 * lane, ch0 = cg * 8;
    const size_t row0 = (size_t)b * SEQ + (size_t)(ch0 + wave) * 32;
    u32x2 hs2[16], ap2[16], ay[16];
#pragma unroll
    for (int u = 0; u < 16; ++u) { const size_t row = row0 + u; hs2[u] = *(const u32x2*)(HS + row * LRUW + c); ap2[u] = *(const u32x2*)(AP + row * LRUW + c); ay[u] = *(const u32x2*)(proj + row * DINP + C_AY + c); }
    const float* tp = TOT + ((size_t)(b * 128) * 2) * LRUW + c;
    LAS f32x4* sl = (LAS f32x4*)lds;
    {   f32x4 Ac = {1.f, 1.f, 1.f, 1.f}, Bc = {0.f, 0.f, 0.f, 0.f};
#pragma unroll
        for (int h2 = 0; h2 < 2; ++h2) {
            f32x4 A[8], B[8];
#pragma unroll
            for (int u = 0; u < 8; ++u) { const int uu = h2 * 8 + u; const int k = wave * cg + (uu < cg ? uu : 0);
                A[u] = *(const f32x4*)(tp + (size_t)k * 2 * LRUW); B[u] = *(const f32x4*)(tp + (size_t)k * 2 * LRUW + LRUW);
                if (uu >= cg) { A[u] = (f32x4){1.f, 1.f, 1.f, 1.f}; B[u] = (f32x4){0.f, 0.f, 0.f, 0.f}; } }
#pragma unroll
            for (int u = 0; u < 8; ++u) { Bc = A[u] * Bc + B[u]; Ac = A[u] * Ac; }
        }
        sl[(wave * 64 + lane) * 2] = Ac; sl[(wave * 64 + lane) * 2 + 1] = Bc;
    }
    __syncthreads();
    f32x4 H = {0.f, 0.f, 0.f, 0.f};
#pragma unroll
    for (int sidx = 0; sidx < 8; ++sidx) { const f32x4 As = sl[(sidx * 64 + lane) * 2], Bs = sl[(sidx * 64 + lane) * 2 + 1]; H = As * H + Bs; }
    {   f32x4 A[8], B[8];
#pragma unroll
        for (int u = 0; u < 8; ++u) { const int k = ch0 + (u < wave ? u : 0);
            A[u] = *(const f32x4*)(tp + (size_t)k * 2 * LRUW); B[u] = *(const f32x4*)(tp + (size_t)k * 2 * LRUW + LRUW);
            if (u >= wave) { A[u] = (f32x4){1.f, 1.f, 1.f, 1.f}; B[u] = (f32x4){0.f, 0.f, 0.f, 0.f}; } }
#pragma unroll
        for (int u = 0; u < 8; ++u) H = A[u] * H + B[u];
    }
#pragma unroll
    for (int half = 0; half < 2; ++half) {
        if (half == 1) {
#pragma unroll
            for (int u = 0; u < 16; ++u) { const size_t row = row0 + 16 + u; hs2[u] = *(const u32x2*)(HS + row * LRUW + c); ap2[u] = *(const u32x2*)(AP + row * LRUW + c); ay[u] = *(const u32x2*)(proj + row * DINP + C_AY + c); }
            const int cc = (8 * lane) & 127;
            const f32x4 g0 = *(const f32x4*)(subg + cc) * nscale, g1 = *(const f32x4*)(subg + cc + 4) * nscale;
#pragma unroll
            for (int q = 0; q < 8; ++q) {
                const f32x4 a0 = {bflo(wa[q].x), bfhi(wa[q].x), bflo(wa[q].y), bfhi(wa[q].y)}, a1 = {bflo(wa[q].z), bfhi(wa[q].z), bflo(wa[q].w), bfhi(wa[q].w)};
                const f32x4 b0 = {bflo(wb[q].x), bfhi(wb[q].x), bflo(wb[q].y), bfhi(wb[q].y)}, b1 = {bflo(wb[q].z), bfhi(wb[q].z), bflo(wb[q].w), bfhi(wb[q].w)};
                const f32x4 c0 = a0 - b0 * lam, c1 = a1 - b1 * lam;
                float ss = (c0[0] * c0[0] + c0[1] * c0[1]) + (c0[2] * c0[2] + c0[3] * c0[3]) + (c1[0] * c1[0] + c1[1] * c1[1]) + (c1[2] * c1[2] + c1[3] * c1[3]);
                ss += shx(ss, 1, lane); ss += shx(ss, 2, lane); ss += shx(ss, 4, lane); ss += shx(ss, 8, lane);
                const float rn = __builtin_amdgcn_rsqf(ss * (1.f / 128.f) + EPS);
                const f32x4 v0 = c0 * rn * g0, v1 = c1 * rn * g1;
                u32x4 w; w.x = cvt_pk_bf16(v0[0], v0[1]); w.y = cvt_pk_bf16(v0[2], v0[3]); w.z = cvt_pk_bf16(v1[0], v1[1]); w.w = cvt_pk_bf16(v1[2], v1[3]);
                *(u32x4*)(cat + (crow0 + q) * DM + CC_DIFF + 8 * lane) = w; }
        }
#pragma unroll
        for (int u = 0; u < 16; ++u) { const size_t row = row0 + half * 16 + u;
            const f32x4 hs = {bflo(hs2[u].x), bfhi(hs2[u].x), bflo(hs2[u].y), bfhi(hs2[u].y)}, ap = {bflo(ap2[u].x), bfhi(ap2[u].x), bflo(ap2[u].y), bfhi(ap2[u].y)};
            const f32x4 v = hs + ap * H;
            u32x2 w; w.x = cvt_pk_bf16(v[0] * gelu_tanh(bflo(ay[u].x)), v[1] * gelu_tanh(bfhi(ay[u].x))); w.y = cvt_pk_bf16(v[2] * gelu_tanh(bflo(ay[u].y)), v[3] * gelu_tanh(bfhi(ay[u].y)));
            *(u32x2*)(cat + row * DM + CC_LRU + c) = w; }
    }
    __syncthreads();
}
__device__ __forceinline__ void diff_combine_rows4(size_t row0, const bf16* D1, const bf16* D2, const float* subg, float lam, float nscale, bf16* cat, int lane) {
    f32x4 a0[4], a1[4], b0[4], b1[4];
#pragma unroll
    for (int q = 0; q < 4; ++q) { const size_t o = (row0 + q) * 512 + 8 * lane;
        const u32x4 wa = *(const u32x4*)(D1 + o), wb = *(const u32x4*)(D2 + o);
        a0[q] = (f32x4){bflo(wa.x), bfhi(wa.x), bflo(wa.y), bfhi(wa.y)}; a1[q] = (f32x4){bflo(wa.z), bfhi(wa.z), bflo(wa.w), bfhi(wa.w)};
        b0[q] = (f32x4){bflo(wb.x), bfhi(wb.x), bflo(wb.y), bfhi(wb.y)}; b1[q] = (f32x4){bflo(wb.z), bfhi(wb.z), bflo(wb.w), bfhi(wb.w)}; }
    const int c = (8 * lane) & 127;
    const f32x4 g0 = *(const f32x4*)(subg + c) * nscale, g1 = *(const f32x4*)(subg + c + 4) * nscale;
#pragma unroll
    for (int q = 0; q < 4; ++q) {
        const f32x4 c0 = a0[q] - b0[q] * lam, c1 = a1[q] - b1[q] * lam;
        float ss = (c0[0] * c0[0] + c0[1] * c0[1]) + (c0[2] * c0[2] + c0[3] * c0[3]) + (c1[0] * c1[0] + c1[1] * c1[1]) + (c1[2] * c1[2] + c1[3] * c1[3]);
        ss += shx(ss, 1, lane); ss += shx(ss, 2, lane); ss += shx(ss, 4, lane); ss += shx(ss, 8, lane);
        const float rn = __builtin_amdgcn_rsqf(ss * (1.f / 128.f) + EPS);
        const f32x4 v0 = c0 * rn * g0, v1 = c1 * rn * g1;
        u32x4 w; w.x = cvt_pk_bf16(v0[0], v0[1]); w.y = cvt_pk_bf16(v0[2], v0[3]); w.z = cvt_pk_bf16(v1[0], v1[1]); w.w = cvt_pk_bf16(v1[2], v1[3]);
        *(u32x4*)(cat + (row0 + q) * DM + CC_DIFF + 8 * lane) = w; }
}
__device__ __forceinline__ int fresh_tid(int wave) { int w_ = wave; asm volatile("" : "+s"(w_)); int t_; asm volatile("v_mbcnt_lo_u32_b32 %0, -1, 0\n\tv_mbcnt_hi_u32_b32 %0, -1, %0" : "=v"(t_)); return t_ + w_ * 64; }
__device__ __forceinline__ int dequeue(unsigned* head, volatile LAS unsigned* slot, int wave) {
    if (fresh_tid(wave) == 0) *slot = __hip_atomic_fetch_add(head, 1u, __ATOMIC_RELAXED, __HIP_MEMORY_SCOPE_AGENT);
    __syncthreads(); const int v = __builtin_amdgcn_readfirstlane((int)*slot); __syncthreads(); return v;
}

__device__ __forceinline__ int dequeue_x(unsigned* heads, volatile LAS unsigned* slot, int wave, int x0, unsigned per_q) {
    if (fresh_tid(wave) == 0) {
        unsigned r = 0xFFFFFFFFu;
        for (int t = 0; t < 8; ++t) { const unsigned x = (unsigned)(x0 + t) & 7u; const unsigned i = __hip_atomic_fetch_add(heads + 16 * x, 1u, __ATOMIC_RELAXED, __HIP_MEMORY_SCOPE_AGENT); if (i < per_q) { r = (x << 7) | i; break; } }
        *slot = r;
    }
    __syncthreads(); const int v = __builtin_amdgcn_readfirstlane((int)*slot); __syncthreads(); return v;
}

constexpr int PH_PRO = 3, PH_PER_LAYER = 14, NPH = PH_PRO + DEPTH * PH_PER_LAYER;
struct Args { const float* in[21]; float* out; unsigned char* ws; int ph_lo, ph_hi; };

#define WSB(off) (((unsigned char*)karg(I_WS)) + (off))
#define P_HB   ((bf16*)WSB(WS_XN))
#define P_RS   ((float*)WSB(WS_FL + 768 * 1024))
#define P_HFF  ((bf16*)WSB(WS_HFF))
#define P_PROJ ((bf16*)WSB(WS_PROJ))
#define P_CAT  ((bf16*)WSB(WS_CAT))
#define P_PB   ((bf16*)WSB(WS_PB))
#define P_Y    ((bf16*)WSB(WS_Y))
#define P_HS   ((bf16*)WSB(WS_HS))
#define P_AP   ((bf16*)WSB(WS_AP))
#define P_D1   ((bf16*)WSB(WS_D1))
#define P_D2   ((bf16*)WSB(WS_D2))
#define P_TOT  ((float*)WSB(WS_TOT))
#define P_FL   ((float*)WSB(WS_FL))
#define P_CUM  ((float*)WSB(WS_CUM))
#define P_H    ((float*)karg(I_OUT))

#define IN(k) (lo <= (k) && (k) < hi_ph)
#define SEAM(k) do { if (IN(k) && IN((k) + 1)) { XcdBarrier bb_; bb_.bar = (unsigned*)WSB(WS_CTL) + CW_BAR; bb_.x = xb_xcc_id(); bb_.st = (volatile LAS unsigned*)(ldsb + MISC_OFF) + 8; xcd_barrier(bb_); } } while (0)
#define OPQ int bx = (int)blockIdx.x; asm volatile("" : "+s"(bx)); int lq = l; asm volatile("" : "+s"(lq)); (void)lq; \
    Ctx F; { int w_ = wave_s; asm volatile("" : "+s"(w_)); int t_; asm volatile("v_mbcnt_lo_u32_b32 %0, -1, 0\n\tv_mbcnt_hi_u32_b32 %0, -1, %0" : "=v"(t_)); t_ += w_ * 64; F.lds = (LAS unsigned char*)lds; F.tid = t_; F.lane = t_ & 63; F.wave = __builtin_amdgcn_readfirstlane(t_ >> 6); \
             F.G = gridDim.x; F.vcu = (F.G % 8 == 0) ? (bx % 8) * (F.G / 8) + bx / 8 : bx; }

template <int L>
__device__ __forceinline__ void layer_phases(const int rep, const int lo, const int hi_ph, LAS unsigned char* const ldsb, const int wave_s, unsigned char* const lds) {
        constexpr int l = L;
        const int pb = PH_PRO + PH_PER_LAYER * l;
#define LIN(k) (IN(pb + (k)) && (rep == 0 || ((PROBE_DUP >> (k)) & 1u)))
#define LSEAM(k) do { if (rep == 0 ? (IN(pb + (k)) && IN(pb + (k) + 1)) : (((PROBE_DUP >> (k)) & 1u) != 0u)) { XcdBarrier bb_; bb_.bar = (unsigned*)WSB(WS_CTL) + CW_BAR; bb_.x = xb_xcc_id(); bb_.st = (volatile LAS unsigned*)(ldsb + MISC_OFF) + 8; xcd_barrier(bb_); } } while (0)
#define NG(k) (karg(I_NORMG) + ((size_t)lq * 8 + (k)) * DM)
        if (LIN(0)) { OPQ; pg8::Gemm g{DM, DM, DM};
            pg8::Ord S{(const char*)P_HB, (const char*)WSB(WS_W1I) + (size_t)lq * 2 * DFF * DM * 2, (size_t)256 * DM * 2, (size_t)256 * DM * 2, 0, M / 256, 2 * DFF / 256, F.G, bx, DFF, 128};
            pg8::EpiSwiGLU E{P_HFF, DFF, P_RS};
            pg8::gemm_phase<pg8::EpiSwiGLU, pg8::Ord, true>(F.lds, g, S, E); }
        LSEAM(0);
        if (LIN(1)) { OPQ; pg8::Gemm g{DFF, DFF, DFF};
            pg8::Ord S{(const char*)P_HFF, (const char*)WSB(WS_W1O) + (size_t)lq * DM * DFF * 2, (size_t)256 * DFF * 2, (size_t)256 * DFF * 2, 0, M / 256, DM / 256, F.G, bx, DM, 256};
            pg8::EpiBf16 E{P_Y, DM, 1.f, nullptr};
            pg8::gemm_phase<pg8::EpiBf16, pg8::Ord, true>(F.lds, g, S, E); }
        LSEAM(1);
        if (LIN(2)) { OPQ; norm_phase(F, nullptr, P_HB, P_Y, 0.5f, NG(1), NG(2), P_HB, P_RS, nullptr, karg(I_WIN) + (size_t)lq * DM * DIN + DINP, P_FL); }
        LSEAM(2);
        if (LIN(3)) { OPQ;
            if (bx < 16 && F.wave == 0) cum_wave(P_FL, karg(I_FBIAS) + lq * 4, P_CUM, bx, F.lane);
            pg8::Gemm g{DM, DM, DM};
            pg8::Ord S{(const char*)P_HB, (const char*)WSB(WS_WIN) + (size_t)lq * DINP * DM * 2, (size_t)256 * DM * 2, (size_t)256 * DM * 2, 0, M / 256, DINP / 256, F.G, bx, DINP, 256};
            pg8::EpiBf16 E{P_PROJ, DINP, 1.f, P_RS};
            pg8::gemm_phase<pg8::EpiBf16, pg8::Ord, true>(F.lds, g, S, E); }
        LSEAM(3);
        if (LIN(4)) { OPQ;
            char* alds = (char*)lds;
            unsigned* qhead = (unsigned*)WSB(WS_CTL) + CW_Q + 128 * lq;
            const int xq = (int)(xb_xcc_id() & 7u);
            volatile LAS unsigned* qslot = (volatile LAS unsigned*)(ldsb + MISC_OFF) + 16;
            constexpr unsigned PER_Q = 128;
#define IS_LRU(i_) (((i_) & 127) < 32)
#define DEQ() dequeue_x(qhead, qslot, F.wave, xq, PER_Q)
            {
                float* tb = (float*)(alds + att::OFF_T5); const float* relb = karg(I_RELB);
                for (int i = F.tid; i < 4 * 192; i += 512) { const int h = i / 192, t = i - 192 * h; float v = 0.f;
                    if (t >= 1) { const int rel = t - 128, n = rel < 0 ? -rel : rel;
                        int bk = n < 8 ? n : (n >= 91 ? 15 : n >= 64 ? 14 : n >= 46 ? 13 : n >= 32 ? 12 : n >= 23 ? 11 : n >= 16 ? 10 : n >= 12 ? 9 : 8);
                        if (rel > 0) bk += 16;
                        v = (relb[bk * 4 + h] - relb[15 * 4 + h]) * (1.f / SCALE_DIFF); }
                    tb[i] = v; }
            }
            int qi = DEQ();
            while (qi >= 0) {
              if (IS_LRU(qi)) {
                const int li = (qi >> 7) * 32 + (qi & 127);
                for (int half = 0; half < 2; ++half)
                    lru_local_item(li * 16 + half * 8 + F.wave, F.lds + F.wave * 8704, F.lds + att::OFF_OST + F.wave * 4096, P_PROJ, karg(I_CONVW) + (size_t)lq * 4 * LRUW, karg(I_CONVB) + (size_t)lq * LRUW, (const bf16*)WSB(WS_GW) + (size_t)lq * 2 * 8 * 16384,
                                   karg(I_GATEB) + (size_t)lq * 2 * LRUW, karg(I_LAM) + (size_t)lq * LRUW, P_HS, P_AP, P_TOT, fresh_tid(F.wave) & 63);
                qi = DEQ();
                continue;
              }
#define MK_BLK(B_, E_, KIND_, i_) do { const int j_ = ((i_) & 127) - 32, s_ = j_ / 6, r_ = j_ - 6 * s_; KIND_ = r_ >> 1; const int bh_ = 2 * ((i_) >> 7) + (r_ & 1), qb_ = 15 - s_, b_ = bh_ >> 2, h_ = bh_ & 3; \
        const size_t rowb_ = (size_t)b_ * SEQ; const bf16* PR_ = P_PROJ; \
        if (KIND_ == 0) { B_.Q = PR_ + (rowb_ + (size_t)qb_ * 256) * DINP + C_FQ + h_ * 128; B_.K = PR_ + rowb_ * DINP + C_FK + h_ * 128; B_.V = PR_ + rowb_ * DINP + C_FV + h_ * 128; B_.kcb = 0; \
                          E_.out = P_CAT + (rowb_ + (size_t)qb_ * 256) * DM + CC_FOX + h_ * 128; E_.ld = DM; } \
        else { const int c_ = KIND_ - 1; B_.Q = PR_ + (rowb_ + (size_t)qb_ * 256) * DINP + C_DQ + h_ * 128 + c_ * 64; B_.K = PR_ + rowb_ * DINP + C_DK + h_ * 128; B_.V = PR_ + rowb_ * DINP + C_DV + h_ * 128; B_.kcb = c_ * 128; \
               E_.out = (c_ ? P_D2 : P_D1) + (rowb_ + (size_t)qb_ * 256) * 512 + h_ * 128; E_.ld = 512; } \
        B_.P0 = qb_ * 256; B_.bh = bh_; } while (0)
              {
                att::Seam S;
                { att::Blk cur; att::EpiCtx Ec; int kc; MK_BLK(cur, Ec, kc, qi); (void)kc; att::attn_prime<0>(cur, alds, S); }
                for (;;) {
                    const int qn = DEQ();
                    const bool na = qn >= 0 && !IS_LRU(qn);
                    att::Blk cur, nxt; att::EpiCtx Ec, En; int kc, kn;
                    MK_BLK(cur, Ec, kc, qi);
                    { const int qx = na ? qn : qi; MK_BLK(nxt, En, kn, qx); (void)kn; (void)En; }
                    if (kc == 0) {
                        const float* cg = P_CUM + (size_t)cur.bh * SEQ; float* cl = (float*)(alds + att::OFF_CUM); const int nk = cur.P0 + 256;
                        { const int t2 = fresh_tid(F.wave); for (int i = t2 * 4; i < nk; i += 2048) *(f32x4*)(cl + i) = *(const f32x4*)(cg + i); }
                        __syncthreads();
                        att::attn_block<0>(cur, nxt, alds, S, Ec, (const float*)(alds + att::OFF_CUM));
                    } else {
                        att::attn_block<1>(cur, nxt, alds, S, Ec, (const float*)(alds + att::OFF_T5) + 192 * (cur.bh & 3));
                    }
                    qi = qn;
                    if (!na) break;
                }
                __syncthreads();
              }
            }
#undef MK_BLK
#undef IS_LRU
#undef DEQ
        }
        LSEAM(4);
        if (LIN(5)) { OPQ; const int gw = F.vcu * 8 + F.wave, NGW = F.G * 8;
            const float lam_init = lq == 0 ? 0.2f : lq == 1 ? 0.3555090675909693f : lq == 2 ? 0.4707130183435842f : 0.5560582041556405f;
            const float* dl = karg(I_DLAM) + (size_t)lq * 4 * 64;
            const float s1 = wave_sum(dl[F.lane] * dl[64 + F.lane], F.lane), s2 = wave_sum(dl[128 + F.lane] * dl[192 + F.lane], F.lane);
            const float lamv = fast_exp(s1) - fast_exp(s2) + lam_init;
            for (int it = F.vcu; it < BATCH * 4 * 16; it += F.G) lru_fix_group(it, F.lds, P_PROJ, P_HS, P_AP, P_TOT, P_CAT, F.wave, F.lane, P_D1, P_D2, karg(I_SUBG) + (size_t)lq * 128, lamv, 1.f - lam_init); }
        LSEAM(5);
        if (LIN(6)) { OPQ; pg8::Gemm g{DM, DM, DM};
            pg8::Ord S{(const char*)P_CAT, (const char*)WSB(WS_WOUT) + (size_t)lq * DM * DM * 2, (size_t)256 * DM * 2, (size_t)256 * DM * 2, 0, M / 256, DM / 256, F.G, bx, DM, 256};
            pg8::EpiBf16 E{P_Y, DM, 1.f, nullptr};
            pg8::gemm_phase<pg8::EpiBf16, pg8::Ord, true>(F.lds, g, S, E); }
        LSEAM(6);
        if (LIN(7)) { OPQ; norm_phase(F, nullptr, P_HB, P_Y, 1.f, NG(3), nullptr, P_HB, P_RS, nullptr, nullptr, nullptr); }
        LSEAM(7);
        if (LIN(8)) { OPQ; pg8::Gemm g{DM, DM, DM};
            pg8::Ord S{(const char*)P_HB, (const char*)WSB(WS_G) + (size_t)lq * 4 * 1024 * DM * 2, (size_t)256 * DM * 2, (size_t)256 * DM * 2, (size_t)1024 * DM * 2, M / 256, 4, F.G, bx, 1024, 256};
            pg8::EpiSoftmax E{P_PB, 1024, P_RS};
            pg8::gemm_phase<pg8::EpiSoftmax, pg8::Ord, false>(F.lds, g, S, E); }
        LSEAM(8);
        if (LIN(9)) { OPQ; pg8::Gemm g{1024, 1024, 1024};
            pg8::Ord S{(const char*)P_PB, (const char*)WSB(WS_UT) + (size_t)lq * 4 * DM * 1024 * 2, (size_t)256 * 1024 * 2, (size_t)256 * 1024 * 2, (size_t)DM * 1024 * 2, M / 256, DM / 256, F.G, bx, DM, 256};
            pg8::EpiBf16 E{P_Y, DM, 1.f, nullptr};
            pg8::gemm_phase<pg8::EpiBf16, pg8::Ord, true>(F.lds, g, S, E); }
        LSEAM(9);
        if (LIN(10)) { OPQ; norm_phase(F, nullptr, P_HB, P_Y, 1.f, NG(5), nullptr, P_HB, P_RS, nullptr, nullptr, nullptr); }
        LSEAM(10);
        if (LIN(11)) { OPQ; pg8::Gemm g{DM, DM, DM};
            pg8::Ord S{(const char*)P_HB, (const char*)WSB(WS_W2I) + (size_t)lq * 2 * DFF * DM * 2, (size_t)256 * DM * 2, (size_t)256 * DM * 2, 0, M / 256, 2 * DFF / 256, F.G, bx, DFF, 128};
            pg8::EpiSwiGLU E{P_HFF, DFF, P_RS};
            pg8::gemm_phase<pg8::EpiSwiGLU, pg8::Ord, true>(F.lds, g, S, E); }
        LSEAM(11);
        if (LIN(12)) { OPQ; pg8::Gemm g{DFF, DFF, DFF};
            pg8::Ord S{(const char*)P_HFF, (const char*)WSB(WS_W2O) + (size_t)lq * DM * DFF * 2, (size_t)256 * DFF * 2, (size_t)256 * DFF * 2, 0, M / 256, DM / 256, F.G, bx, DM, 256};
            pg8::EpiBf16 E{P_Y, DM, 1.f, nullptr};
            pg8::gemm_phase<pg8::EpiBf16, pg8::Ord, true>(F.lds, g, S, E); }
        LSEAM(12);
        if (LIN(13)) { OPQ; norm_phase(F, nullptr, P_HB, P_Y, 0.5f, NG(7), nullptr, (lq + 1 < DEPTH) ? P_HB : nullptr, P_RS, (lq + 1 < DEPTH) ? nullptr : P_H, nullptr, nullptr);
            if (l + 1 < DEPTH && rep == 0) { __syncthreads(); prologue_convert(F, WSB(0), lq + 1, lq + 2, false); } }
        LSEAM(13);
#undef LIN
#undef LSEAM
#undef NG
}

__global__ void __launch_bounds__(512, 2) trunk_fwd(Args args) {
    extern __shared__ __attribute__((aligned(16))) unsigned char lds[];
    LAS unsigned char* const ldsb = (LAS unsigned char*)lds;
    const int wave_s = __builtin_amdgcn_readfirstlane((int)threadIdx.x >> 6);
    for (int u = threadIdx.x; u < (LDS_BYTES - LDSCTL_OFF) / 4; u += 512) ((LAS unsigned*)(ldsb + LDSCTL_OFF))[u] = 0u;
    __syncthreads();
    const int lo = args.ph_lo, hi_ph = args.ph_hi;
    if (hi_ph - lo > 1) (void)xcd_barrier_post((unsigned*)WSB(WS_CTL) + CW_BAR, (volatile LAS unsigned*)(ldsb + MISC_OFF) + 8);
    { const int l = 0;
    if (IN(0)) { OPQ; prologue_convert(F, WSB(0), 0, 1, true); __syncthreads();
        norm_phase(F, karg(I_X), nullptr, nullptr, 0.f, nullptr, nullptr, P_HB, P_RS, nullptr, nullptr, nullptr); }
    SEAM(0);
    if (IN(1)) { OPQ; pg8::Gemm g{DM, DM, DM};
        pg8::Ord S{(const char*)WSB(WS_MEMB), (const char*)WSB(WS_WKVT), (size_t)256 * DM * 2, (size_t)256 * DM * 2, 0, MROWS / 256, DEPTH * 2 * DM / 256, F.G, bx, DEPTH * 2 * DM, 256};
        pg8::EpiBf16 E{(bf16*)WSB(WS_KVALL), DEPTH * 2 * DM, 1.f, nullptr};
        pg8::gemm_phase<pg8::EpiBf16, pg8::Ord, true>(F.lds, g, S, E); }
    SEAM(1);
    if (IN(2)) { OPQ;
        { pg8::Gemm g{DEPTH * 2 * DM, DM, 512}; pg8::OrdG S{(const char*)WSB(WS_KVALL), (const char*)WSB(WS_WQB), F.G, bx};
          pg8::EpiBf16 E{(bf16*)WSB(WS_G), DM, SCALE_X, nullptr};
          pg8::gemm_phase<pg8::EpiBf16, pg8::OrdG, true>(F.lds, g, S, E); }
        { pg8::Gemm g{DM, DEPTH * 2 * DM, 512}; pg8::OrdU S{(const char*)WSB(WS_KVALL), (const char*)WSB(WS_WOT), F.G, bx};
          pg8::EpiBf16 E{(bf16*)WSB(WS_UT), 1024, 1.f, nullptr};
          pg8::gemm_phase<pg8::EpiBf16, pg8::OrdU, true>(F.lds, g, S, E); }
    }
    SEAM(2);
    }

    layer_phases<0>(0, lo, hi_ph, ldsb, wave_s, lds); if (PROBE_DUP) layer_phases<0>(1, lo, hi_ph, ldsb, wave_s, lds);
    layer_phases<1>(0, lo, hi_ph, ldsb, wave_s, lds); if (PROBE_DUP) layer_phases<1>(1, lo, hi_ph, ldsb, wave_s, lds);
    layer_phases<2>(0, lo, hi_ph, ldsb, wave_s, lds); if (PROBE_DUP) layer_phases<2>(1, lo, hi_ph, ldsb, wave_s, lds);
    layer_phases<3>(0, lo, hi_ph, ldsb, wave_s, lds); if (PROBE_DUP) layer_phases<3>(1, lo, hi_ph, ldsb, wave_s, lds);
#undef IN
#undef SEAM
}

extern "C" void kernel_launch(void* const* d_in, const int* in_sizes, int n_in, void* d_out, int out_size, void* d_ws, size_t ws_size, hipStream_t stream) {
    static int grid = 0;
    if (grid == 0) {
        if (n_in != 21 || in_sizes[0] != M * DM || out_size != M * DM || ws_size < WS_END) { fprintf(stderr, "kernel_launch: unexpected shapes (n_in %d, in0 %d, out %d, ws %zu < %zu)\n", n_in, n_in > 0 ? in_sizes[0] : -1, out_size, ws_size, (size_t)WS_END); grid = -1; return; }
        int dev = 0, cus = 0, per_cu = 0;
        if (hipGetDevice(&dev) != hipSuccess || hipDeviceGetAttribute(&cus, hipDeviceAttributeMultiprocessorCount, dev) != hipSuccess) { grid = -1; return; }
        if (hipFuncSetAttribute((const void*)trunk_fwd, hipFuncAttributeMaxDynamicSharedMemorySize, LDS_BYTES) != hipSuccess) { fprintf(stderr, "kernel_launch: hipFuncSetAttribute failed\n"); grid = -1; return; }
        if (hipOccupancyMaxActiveBlocksPerMultiprocessor(&per_cu, (const void*)trunk_fwd, 512, LDS_BYTES) != hipSuccess || per_cu < 1) fprintf(stderr, "kernel_launch: occupancy query reports %d blocks per CU\n", per_cu);
        (void)hipGetLastError();
        grid = cus;
    }
    if (grid < 0) return;
    (void)hipMemsetAsync((char*)d_ws + WS_CTL, 0, CTL_ZERO_BYTES, stream);
    Args a{};
    for (int i = 0; i < 21; ++i) a.in[i] = (const float*)d_in[i];
    a.out = (float*)d_out; a.ws = (unsigned char*)d_ws;
#if MK_ONE_LAUNCH
    a.ph_lo = 0; a.ph_hi = NPH;
    hipLaunchKernelGGL(trunk_fwd, dim3(grid), dim3(512), LDS_BYTES, stream, a);
#else
    for (int p = 0; p < NPH; ++p) { a.ph_lo = p; a.ph_hi = p + 1; hipLaunchKernelGGL(trunk_fwd, dim3(grid), dim3(512), LDS_BYTES, stream, a); }
#endif
}
```

```cpp
#include <hip/hip_runtime.h>
#include <cstdio>
#include <cstdint>

#ifndef PROBE_DUP
#define PROBE_DUP 0u
#endif
#ifndef MK_ONE_LAUNCH
#define MK_ONE_LAUNCH 1
#endif

#define LAS __attribute__((address_space(3)))
#define GAS __attribute__((address_space(1)))
typedef unsigned short bf16;
typedef short bf16x8 __attribute__((ext_vector_type(8)));
typedef short s16x4 __attribute__((ext_vector_type(4)));
typedef float f32x2 __attribute__((ext_vector_type(2)));
typedef float f32x4 __attribute__((ext_vector_type(4)));
typedef float f32x16 __attribute__((ext_vector_type(16)));
typedef unsigned u32x2 __attribute__((ext_vector_type(2)));
typedef unsigned u32x4 __attribute__((ext_vector_type(4)));
typedef GAS unsigned gu32;

constexpr int BATCH = 4, SEQ = 4096, M = BATCH * SEQ, DM = 2048, DEPTH = 4, DFF = 5632, DIN = 5124, DINP = 5120, NMEM = 256, MROWS = BATCH * NMEM;
constexpr int LRUW = 1024;
constexpr float EPS = 1e-6f;
constexpr int C_AX = 0, C_AY = 1024, C_DQ = 2048, C_DK = 2560, C_DV = 3072, C_FQ = 3584, C_FK = 4096, C_FV = 4608;
constexpr int CC_LRU = 0, CC_DIFF = 1024, CC_FOX = 1536;
constexpr float SCALE_FOX = 0.08838834764831845f, SCALE_DIFF = 0.125f, SCALE_X = 0.04419417382415922f;

constexpr size_t MiB = 1u << 20;
constexpr size_t WS_CTL = 0, CTL_ZERO_BYTES = 1 * MiB;
constexpr size_t WS_W1I = 1 * MiB, WS_W1O = 177 * MiB, WS_W2I = 265 * MiB, WS_W2O = 441 * MiB, WS_WIN = 529 * MiB, WS_WOUT = 609 * MiB, WS_GW = 641 * MiB;
constexpr size_t WS_G = 643 * MiB, WS_UT = 707 * MiB, WS_XN = 771 * MiB, WS_HFF = 835 * MiB, WS_CAT = 1011 * MiB, WS_PB = 1075 * MiB, WS_Y = 1107 * MiB;
constexpr size_t WS_D1 = 1235 * MiB, WS_TOT = 1267 * MiB, WS_FL = 1271 * MiB, WS_CUM = WS_FL + 512 * 1024, WS_D2 = 1272 * MiB, WS_END = 1304 * MiB;
constexpr size_t WS_PROJ = WS_HFF;
constexpr size_t WS_HS = WS_Y, WS_AP = WS_Y + 64 * MiB;
constexpr size_t WS_WQB = 835 * MiB, WS_WKVT = 867 * MiB, WS_WOT = 931 * MiB, WS_KVALL = 963 * MiB, WS_MEMB = 995 * MiB;
static_assert(WS_MEMB + (size_t)MROWS * DM * 2 <= WS_CAT, "prologue buffers inside HFF region");
constexpr int CW_TMO = 0, CW_BAR = 4096, CW_Q = 8192;

constexpr int RING_BYTES = 131072, LDSCTL_OFF = RING_BYTES, MISC_OFF = LDSCTL_OFF + 320, LDS_BYTES = 147456;

__device__ __forceinline__ unsigned cvt_pk_bf16(float lo, float hi) { unsigned r; asm volatile("v_cvt_pk_bf16_f32 %0, %1, %2" : "=v"(r) : "v"(lo), "v"(hi)); return r; }
__device__ __forceinline__ float bflo(unsigned u) { return __uint_as_float(u << 16); }
__device__ __forceinline__ float bfhi(unsigned u) { return __uint_as_float(u & 0xffff0000u); }
__device__ __forceinline__ float shx(float v, int m, int lane) { return __uint_as_float((unsigned)__builtin_amdgcn_ds_bpermute((lane ^ m) << 2, (int)__float_as_uint(v))); }
__device__ __forceinline__ float wave_sum(float v, int lane) {
#pragma unroll
    for (int o = 1; o < 64; o <<= 1) v += shx(v, o, lane);
    return v;
}
__device__ __forceinline__ float sigmoidf_(float x) { return __builtin_amdgcn_rcpf(1.f + __builtin_amdgcn_exp2f(-1.4426950408889634f * x)); }
__device__ __forceinline__ float gelu_tanh(float x) { const float u = 0.7978845608028654f * (x + 0.044715f * x * x * x); return x * sigmoidf_(2.f * u); }
__device__ __forceinline__ float log1p_small(float e) { const float ser = e * (1.f - e * (0.5f - e * (1.f / 3.f))); const float lg = __builtin_amdgcn_logf(1.f + e) * 0.6931471805599453f; return e < 0.01f ? ser : lg; }
__device__ __forceinline__ float fast_exp(float x) { return __builtin_amdgcn_exp2f(x * 1.4426950408889634f); }
__device__ __forceinline__ int crow(int r, int hi) { return (r & 3) + 8 * (r >> 2) + 4 * hi; }
#define LDS_WAIT() asm volatile("s_waitcnt lgkmcnt(0)" ::: "memory")
#define VM_WAIT() asm volatile("s_waitcnt vmcnt(0)" ::: "memory")

namespace pg8 {
constexpr int BM = 256, BK = 64, HALF = 128, HTB = HALF * BK * 2, STAGE_BYTES = 8 * HTB, NXCD = 8, WGM = 4;
__host__ __device__ __forceinline__ int lds_byte(int r, int c) { return (r >> 3) * 1024 + (r & 7) * 128 + ((((c >> 3) ^ (r >> 1)) & 7) * 16) + (c & 7) * 2; }
__host__ __device__ __forceinline__ void stage_rc(int b, int& R, int& C) { const int piece = b / 1024, sb = b % 1024, rr = sb / 128, pos = (sb % 128) / 16; R = piece * 8 + rr; C = ((pos ^ (R >> 1)) & 7) * 8; }
__host__ __device__ __forceinline__ int perm32(int rho) { const int n = rho >> 4, i = rho & 15; return 8 * (i >> 2) + 4 * n + (i & 3); }

struct Unit { int pm, pn; const char* a; const char* b; size_t ooff; };
struct Gemm { int lda, ldb, K; };

struct Ord {
    const char* A; const char* B; size_t a_tile, b_tile, b_batch; int nM, nN, G, c, ldc, ocols;
    __device__ __forceinline__ bool next(int i, Unit& u) const {
        const int nwg = nM * nN; const long L = (long)i * G + c; if (L >= nwg) return false;
        int wgid = (int)L; { const int q = nwg / NXCD, r = nwg % NXCD, xcd = wgid % NXCD, off = wgid / NXCD; wgid = (xcd < r ? xcd * (q + 1) : r * (q + 1) + (xcd - r) * q) + off; }
        const int nig = WGM * nN, gid = wgid / nig, fm = gid * WGM, gsz = (nM - fm) < WGM ? (nM - fm) : WGM;
        u.pm = fm + ((wgid % nig) % gsz); u.pn = (wgid % nig) / gsz;
        u.a = A + (size_t)u.pm * a_tile; u.b = B + (size_t)u.pn * b_tile + (size_t)(u.pm >> 4) * b_batch;
        u.ooff = (size_t)u.pm * 256 * ldc + (size_t)u.pn * ocols; return true;
    }
};
struct OrdG {
    const char* KV; const char* WQ; int G, c;
    __device__ __forceinline__ bool next(int i, Unit& u) const {
        const long L = (long)i * G + c; if (L >= 512) return false;
        const int z = (int)L >> 3, pn = (int)L & 7, l = z >> 4, b = (z >> 2) & 3, h = z & 3;
        u.pm = 0; u.pn = pn;
        u.a = KV + ((size_t)(b * 256) * 16384 + l * 4096 + h * 512) * 2;
        u.b = WQ + ((size_t)l * DM * DM + (size_t)(pn * 256) * DM + h * 512) * 2;
        u.ooff = ((size_t)(l * 4 + b) * 1024 + h * 256) * DM + pn * 256; return true;
    }
};
struct OrdU {
    const char* KV; const char* WOT; int G, c;
    __device__ __forceinline__ bool next(int i, Unit& u) const {
        const long L = (long)i * G + c; if (L >= 512) return false;
        const int z = (int)L >> 3, pm = (int)L & 7, l = z >> 4, b = (z >> 2) & 3, h = z & 3;
        u.pm = pm; u.pn = 0;
        u.a = WOT + ((size_t)l * DM * DM + (size_t)(pm * 256) * DM + h * 512) * 2;
        u.b = KV + ((size_t)(b * 256) * 16384 + l * 4096 + 2048 + h * 512) * 2;
        u.ooff = ((size_t)(l * 4 + b) * DM + pm * 256) * 1024 + h * 256; return true;
    }
};

struct EpiBf16 {
    static constexpr bool PERM = true, AFTER_DRAIN = false;
    bf16* O; int ldc; float scale; const float* rs;
    __device__ __forceinline__ void operator()(const f32x4 (&acc)[2][2][4][2], const Unit& u, int wr, int wc, int fr, int fq) const {
        bf16* base = O + u.ooff + (size_t)(wr * 64 + fr) * ldc + wc * 32 + 8 * fq;
        const float* rsp = rs ? rs + u.pm * BM + wr * 64 + fr : nullptr;
        float scv[2][4];
#pragma unroll
        for (int ai = 0; ai < 2; ++ai)
#pragma unroll
            for (int m = 0; m < 4; ++m) scv[ai][m] = rsp ? scale * rsp[ai * HALF + m * 16] : scale;
#pragma unroll
        for (int ai = 0; ai < 2; ++ai)
#pragma unroll
            for (int m = 0; m < 4; ++m) { bf16* rowp = base + (size_t)(ai * HALF + m * 16) * ldc; const float sc = scv[ai][m];
#pragma unroll
                for (int bj = 0; bj < 2; ++bj) { const f32x4 v0 = acc[ai][bj][m][0] * sc, v1 = acc[ai][bj][m][1] * sc;
                    u32x4 w; w.x = cvt_pk_bf16(v0[0], v0[1]); w.y = cvt_pk_bf16(v0[2], v0[3]); w.z = cvt_pk_bf16(v1[0], v1[1]); w.w = cvt_pk_bf16(v1[2], v1[3]);
                    *(u32x4*)(rowp + bj * HALF) = w; } }
    }
};
struct EpiSwiGLU {
    static constexpr bool PERM = true, AFTER_DRAIN = false;
    bf16* O; int ldc; const float* rs;
    __device__ __forceinline__ void operator()(const f32x4 (&acc)[2][2][4][2], const Unit& u, int wr, int wc, int fr, int fq) const {
        bf16* base = O + u.ooff + (size_t)(wr * 64 + fr) * ldc + wc * 32 + 8 * fq;
        const float* rsp = rs + u.pm * BM + wr * 64 + fr;
        float scv[2][4];
#pragma unroll
        for (int ai = 0; ai < 2; ++ai)
#pragma unroll
            for (int m = 0; m < 4; ++m) scv[ai][m] = rsp[ai * HALF + m * 16];
#pragma unroll
        for (int ai = 0; ai < 2; ++ai)
#pragma unroll
            for (int m = 0; m < 4; ++m) { bf16* rowp = base + (size_t)(ai * HALF + m * 16) * ldc; const float sc = scv[ai][m];
                const float scl = -1.4426950408889634f * sc, sc2 = sc * sc; f32x4 o4[2];
#pragma unroll
                for (int n = 0; n < 2; ++n) { const f32x4 g = acc[ai][0][m][n], up = acc[ai][1][m][n]; const f32x4 t = g * scl;
                    f32x4 d = (f32x4){__builtin_amdgcn_exp2f(t[0]), __builtin_amdgcn_exp2f(t[1]), __builtin_amdgcn_exp2f(t[2]), __builtin_amdgcn_exp2f(t[3])} + 1.f;
                    const f32x4 r = {__builtin_amdgcn_rcpf(d[0]), __builtin_amdgcn_rcpf(d[1]), __builtin_amdgcn_rcpf(d[2]), __builtin_amdgcn_rcpf(d[3])};
                    o4[n] = ((g * up) * sc2) * r; }
                u32x4 w; w.x = cvt_pk_bf16(o4[0][0], o4[0][1]); w.y = cvt_pk_bf16(o4[0][2], o4[0][3]); w.z = cvt_pk_bf16(o4[1][0], o4[1][1]); w.w = cvt_pk_bf16(o4[1][2], o4[1][3]);
                *(u32x4*)rowp = w; }
    }
};
struct EpiF32 {
    static constexpr bool PERM = false, AFTER_DRAIN = false;
    float* C; int ldc;
    __device__ __forceinline__ void operator()(const f32x4 (&acc)[2][2][4][2], const Unit& u, int wr, int wc, int fr, int fq) const {
        float* base = C + u.ooff + (size_t)(wr * 64 + fr) * ldc + wc * 32 + 4 * fq;
#pragma unroll
        for (int ai = 0; ai < 2; ++ai)
#pragma unroll
            for (int m = 0; m < 4; ++m) { float* rowp = base + (size_t)(ai * HALF + m * 16) * ldc;
#pragma unroll
                for (int bj = 0; bj < 2; ++bj)
#pragma unroll
                    for (int n = 0; n < 2; ++n) *(f32x4*)(rowp + bj * HALF + n * 16) = acc[ai][bj][m][n]; }
    }
};
struct EpiSoftmax {
    static constexpr bool PERM = true, AFTER_DRAIN = true;
    bf16* O; int ldc; const float* rs;
    __device__ __forceinline__ void fused(f32x4 (&acc)[2][2][4][2], const Unit& u, int wr, int wc, int fr, int fq, LAS unsigned char* lds, int wid, int lane) const {
        LAS float* P1 = (LAS float*)lds;
        LAS float* P2 = (LAS float*)(lds + 4096);
        const float* rsp = rs + u.pm * BM + wr * 64 + fr;
#pragma unroll
        for (int ai = 0; ai < 2; ++ai)
#pragma unroll
            for (int m = 0; m < 4; ++m) { float mx = -3.0e38f; const float sc = rsp[ai * HALF + m * 16];
#pragma unroll
                for (int bj = 0; bj < 2; ++bj)
#pragma unroll
                    for (int n = 0; n < 2; ++n) { acc[ai][bj][m][n] = acc[ai][bj][m][n] * sc; const f32x4 x = acc[ai][bj][m][n]; mx = fmaxf(mx, fmaxf(fmaxf(x[0], x[1]), fmaxf(x[2], x[3]))); }
                mx = fmaxf(mx, shx(mx, 16, lane)); mx = fmaxf(mx, shx(mx, 32, lane));
                if (fq == 0) P1[(ai * HALF + wr * 64 + m * 16 + fr) * 4 + wc] = mx; }
        asm volatile("s_waitcnt lgkmcnt(0)" ::: "memory"); __builtin_amdgcn_s_barrier(); asm volatile("" ::: "memory");
#pragma unroll
        for (int ai = 0; ai < 2; ++ai)
#pragma unroll
            for (int m = 0; m < 4; ++m) { const int r = ai * HALF + wr * 64 + m * 16 + fr; const f32x4 q = *(const LAS f32x4*)(P1 + r * 4);
                const float mx = fmaxf(fmaxf(q[0], q[1]), fmaxf(q[2], q[3])) * 1.4426950408889634f; float s = 0.f;
#pragma unroll
                for (int bj = 0; bj < 2; ++bj)
#pragma unroll
                    for (int n = 0; n < 2; ++n) { f32x4 x = acc[ai][bj][m][n];
#pragma unroll
                        for (int e = 0; e < 4; ++e) { x[e] = __builtin_amdgcn_exp2f(x[e] * 1.4426950408889634f - mx); s += x[e]; }
                        acc[ai][bj][m][n] = x; }
                s += shx(s, 16, lane); s += shx(s, 32, lane);
                if (fq == 0) P2[r * 4 + wc] = s; }
        asm volatile("s_waitcnt lgkmcnt(0)" ::: "memory"); __builtin_amdgcn_s_barrier(); asm volatile("" ::: "memory");
        bf16* base = O + u.ooff + (size_t)(wr * 64 + fr) * ldc + wc * 32 + 8 * fq;
#pragma unroll
        for (int ai = 0; ai < 2; ++ai)
#pragma unroll
            for (int m = 0; m < 4; ++m) { const int r = ai * HALF + wr * 64 + m * 16 + fr; const f32x4 q = *(const LAS f32x4*)(P2 + r * 4);
                const float inv = __builtin_amdgcn_rcpf((q[0] + q[1]) + (q[2] + q[3])); bf16* rowp = base + (size_t)(ai * HALF + m * 16) * ldc;
#pragma unroll
                for (int bj = 0; bj < 2; ++bj) { const f32x4 v0 = acc[ai][bj][m][0] * inv, v1 = acc[ai][bj][m][1] * inv;
                    u32x4 w; w.x = cvt_pk_bf16(v0[0], v0[1]); w.y = cvt_pk_bf16(v0[2], v0[3]); w.z = cvt_pk_bf16(v1[0], v1[1]); w.w = cvt_pk_bf16(v1[2], v1[3]);
                    *(u32x4*)(rowp + bj * HALF) = w; } }
        asm volatile("s_waitcnt lgkmcnt(0)" ::: "memory"); __builtin_amdgcn_s_barrier(); asm volatile("" ::: "memory");
    }
};

template <class Epi, class Sched, bool ALIGN_EPI>
__device__ __forceinline__ void gemm_phase(LAS unsigned char* lds, const Gemm g, const Sched& S, const Epi& E) {
    int tid = threadIdx.x; asm volatile("" : "+v"(tid));
    const int wid = __builtin_amdgcn_readfirstlane(tid >> 6), lane = tid & 63, wr = wid >> 2, wc = wid & 3, fr = lane & 15, fq = lane >> 4;
    const int K = g.K, nt = K / BK;
    unsigned voffA[2], voffB[2];
#pragma unroll
    for (int i = 0; i < 2; ++i) { int R, C; stage_rc(tid * 16 + i * 8192, R, C); const int Rb = Epi::PERM ? ((R & ~31) + perm32(R & 31)) : R;
        voffA[i] = (unsigned)(R * g.lda + C) * 2u; voffB[i] = (unsigned)(Rb * g.ldb + C) * 2u; }
    const size_t kstep = (size_t)(BK * 2);
    const size_t hA = (size_t)HALF * g.lda * 2, hB = (size_t)HALF * g.ldb * 2;
    const unsigned ldsw = (unsigned)wid * 1024u;
    const int aoff = lds_byte(wr * 64 + fr, fq * 8), boff = lds_byte(wc * 32 + fr, fq * 8);
#define PG8_SA(b, h) (((b) * 2 + (h)) * HTB)
#define PG8_SB(b, h) ((4 + (b) * 2 + (h)) * HTB)
#define PG8_STAGE(bufoff, gbase, voff) do { _Pragma("unroll") for (int _i = 0; _i < 2; ++_i) \
        __builtin_amdgcn_global_load_lds((const unsigned*)((const char*)(gbase) + (voff)[_i]), (LAS unsigned*)(lds + (bufoff) + ldsw + _i * 8192), 16, 0, 0); } while (0)
#define PG8_LDA(dst, b, h) do { _Pragma("unroll") for (int m = 0; m < 4; ++m) _Pragma("unroll") for (int k = 0; k < 2; ++k) dst[m][k] = *(const LAS bf16x8*)(lds + PG8_SA(b, h) + (aoff ^ (k * 64)) + m * 2048); } while (0)
#define PG8_LDB(dst, b, h) do { _Pragma("unroll") for (int n = 0; n < 2; ++n) _Pragma("unroll") for (int k = 0; k < 2; ++k) dst[n][k] = *(const LAS bf16x8*)(lds + PG8_SB(b, h) + (boff ^ (k * 64)) + n * 2048); } while (0)
#define PG8_MMA(ai, bj, At, Bt) do { __builtin_amdgcn_s_setprio(1); _Pragma("unroll") for (int m = 0; m < 4; ++m) _Pragma("unroll") for (int n = 0; n < 2; ++n) _Pragma("unroll") for (int k = 0; k < 2; ++k) \
        acc[ai][bj][m][n] = __builtin_amdgcn_mfma_f32_16x16x32_bf16(Bt[n][k], At[m][k], acc[ai][bj][m][n], 0, 0, 0); __builtin_amdgcn_s_setprio(0); } while (0)
#define PG8_WAIT_V(n) asm volatile("s_waitcnt vmcnt(" #n ")" ::: "memory")
#define PG8_WAIT_L(n) asm volatile("s_waitcnt lgkmcnt(" #n ")" ::: "memory")
#define PG8_BAR __builtin_amdgcn_s_barrier()
#define PG8_SCHED __builtin_amdgcn_sched_barrier(0)
    Unit cur, nxt; int ui = 0;
    if (!S.next(0, cur)) return;
    f32x4 acc[2][2][4][2];
#pragma unroll
    for (int a = 0; a < 2; ++a)
#pragma unroll
        for (int b = 0; b < 2; ++b)
#pragma unroll
            for (int m = 0; m < 4; ++m)
#pragma unroll
                for (int n = 0; n < 2; ++n) acc[a][b][m][n] = (f32x4){0.f, 0.f, 0.f, 0.f};
    bf16x8 At[4][2], B0[2][2], B1[2][2];
    const char* cA = cur.a; const char* cB = cur.b;
    PG8_STAGE(PG8_SB(0, 0), cB, voffB); PG8_STAGE(PG8_SB(0, 1), cB + hB, voffB); PG8_STAGE(PG8_SA(0, 0), cA, voffA); PG8_STAGE(PG8_SA(0, 1), cA + hA, voffA);
    if (wr == 1) PG8_BAR;
    PG8_WAIT_V(2); PG8_BAR;
    PG8_STAGE(PG8_SB(1, 0), cB + kstep, voffB); PG8_STAGE(PG8_SA(1, 0), cA + kstep, voffA); PG8_STAGE(PG8_SB(1, 1), cB + hB + kstep, voffB);
    PG8_WAIT_V(6); PG8_BAR;
    for (;;) {
        const bool has_next = S.next(ui + 1, nxt);
        const char* nA = has_next ? nxt.a : cA; const char* nB = has_next ? nxt.b : cB;
        for (int t = 0; t < nt; t += 2) {
            const bool last = (t == nt - 2);
            const char* a1 = cA + (size_t)(t + 1) * kstep;
            const char* a2 = last ? nA : cA + (size_t)(t + 2) * kstep; const char* b2 = last ? nB : cB + (size_t)(t + 2) * kstep;
            const char* a3 = a2 + kstep; const char* b3 = b2 + kstep;
            PG8_LDB(B0, 0, 0); PG8_LDB(B1, 0, 1); PG8_SCHED; PG8_LDA(At, 0, 0); PG8_STAGE(PG8_SA(1, 1), a1 + hA, voffA);
            PG8_WAIT_V(8); PG8_WAIT_L(0); PG8_BAR; PG8_MMA(0, 0, At, B0); PG8_MMA(0, 1, At, B1); PG8_BAR; PG8_SCHED;
            PG8_LDA(At, 0, 1); PG8_STAGE(PG8_SB(0, 0), b2, voffB); PG8_STAGE(PG8_SB(0, 1), b2 + hB, voffB); PG8_STAGE(PG8_SA(0, 0), a2, voffA);
            PG8_WAIT_V(8); PG8_WAIT_L(0); PG8_BAR; PG8_MMA(1, 0, At, B0); PG8_MMA(1, 1, At, B1); PG8_BAR; PG8_SCHED;
            PG8_LDB(B0, 1, 0); PG8_LDB(B1, 1, 1); PG8_SCHED; PG8_LDA(At, 1, 0); PG8_STAGE(PG8_SA(0, 1), a2 + hA, voffA);
            PG8_WAIT_V(8); PG8_WAIT_L(0); PG8_BAR; PG8_MMA(0, 0, At, B0); PG8_MMA(0, 1, At, B1); PG8_BAR; PG8_SCHED;
            PG8_LDA(At, 1, 1); PG8_STAGE(PG8_SB(1, 0), b3, voffB); PG8_STAGE(PG8_SB(1, 1), b3 + hB, voffB); PG8_STAGE(PG8_SA(1, 0), a3, voffA);
            PG8_WAIT_V(8); PG8_WAIT_L(0); PG8_BAR; PG8_MMA(1, 0, At, B0); PG8_MMA(1, 1, At, B1); PG8_BAR; PG8_SCHED;
        }
        if constexpr (ALIGN_EPI) { if (wr == 0) PG8_BAR; }
        if constexpr (!Epi::AFTER_DRAIN) { E(acc, cur, wr, wc, fr, fq); }
        if (!has_next) break;
#pragma unroll
        for (int a = 0; a < 2; ++a)
#pragma unroll
            for (int b = 0; b < 2; ++b)
#pragma unroll
                for (int m = 0; m < 4; ++m)
#pragma unroll
                    for (int n = 0; n < 2; ++n) acc[a][b][m][n] = (f32x4){0.f, 0.f, 0.f, 0.f};
        cur = nxt; cA = nA; cB = nB; ++ui;
        if constexpr (ALIGN_EPI) { if (wr == 1) PG8_BAR; }
    }
    PG8_WAIT_V(0);
    if constexpr (!ALIGN_EPI) { if (wr == 0) PG8_BAR; }
    PG8_BAR;
    if constexpr (Epi::AFTER_DRAIN) { E.fused(acc, cur, wr, wc, fr, fq, lds, wid, lane); }
#undef PG8_SA
#undef PG8_SB
#undef PG8_STAGE
#undef PG8_LDA
#undef PG8_LDB
#undef PG8_MMA
#undef PG8_WAIT_V
#undef PG8_WAIT_L
#undef PG8_BAR
#undef PG8_SCHED
}
}

namespace att {
constexpr int NW = 8, QBLK = 32, KVBLK = 64, QB = NW * QBLK, D = 128, LDP = DINP;
constexpr int SHM_V = KVBLK * D * 2, SHM_K = KVBLK * D * 2;
constexpr int OFF_WS = 2 * SHM_V + 2 * SHM_K, OFF_CUM = OFF_WS + NW * 64 * 4, OFF_T5 = OFF_CUM + 16384, OFF_OST = 90112, ATT_LDS = OFF_OST + NW * 4096;
constexpr float THR = 8.f;
#define KSWZ(row, colB) ((row) * 256 + ((colB) ^ (((row) & 7) << 4)))
#define SBAR() __builtin_amdgcn_sched_barrier(0)
__device__ __forceinline__ int v_st(int k, int c) { const int kk = (k & ~0xC) | ((k & 4) << 1) | ((k & 8) >> 1); return ((kk >> 3) * 4 + (c >> 5)) * 512 + ((kk & 7) * 32 + (c & 31)) * 2; }
__device__ __forceinline__ int v_rd_base(int lane) { return ((lane & 3) << 3) | (((lane >> 2) & 3) << 6) | (((lane >> 4) & 1) << 5) | (((lane >> 5) & 1) << 8); }
constexpr int v_rd_off(int d0, int ks, int half) { return d0 * 512 + ks * 4096 + half * 2048; }
__device__ __forceinline__ bf16x8 load8(const bf16* p) { return *reinterpret_cast<const bf16x8*>(p); }

__device__ __forceinline__ void mask_causal(f32x16& p0, f32x16& p1, int dq) {
    const float NEG = -__builtin_inff();
#pragma unroll
    for (int r = 0; r < 16; ++r) { const int c = (r & 3) + 8 * (r >> 2);
        if (dq - c < 0) p0[r] = NEG;
        if (dq - c - 32 < 0) p1[r] = NEG; }
}
__device__ __forceinline__ void bias_t5(f32x16& p0, f32x16& p1, int relbase, const float* tb) {
#pragma unroll
    for (int r = 0; r < 16; ++r) { const int c = (r & 3) + 8 * (r >> 2);
        int i0 = relbase + c; i0 = (i0 < -128 ? -128 : i0) + 128; int i1 = relbase + c + 32; i1 = (i1 < -128 ? -128 : i1) + 128;
        p0[r] += tb[i0]; p1[r] += tb[i1]; }
}
template <int MODE>
__device__ __forceinline__ void partialSM(f32x16& p0, f32x16& p1, float& m_reg, float& mn, float& alpha) {
    constexpr float SCALE = MODE == 0 ? SCALE_FOX : SCALE_DIFF;
    float pmax = p0[0];
#pragma unroll
    for (int r = 1; r < 16; ++r) pmax = fmaxf(pmax, p0[r]);
#pragma unroll
    for (int r = 0; r < 16; ++r) pmax = fmaxf(pmax, p1[r]);
    { auto rr = __builtin_amdgcn_permlane32_swap(__float_as_uint(pmax), __float_as_uint(pmax), false, false);
      pmax = fmaxf(__uint_as_float(rr[0]), __uint_as_float(rr[1])); }
    constexpr float C2 = 1.4426950408889634f * SCALE;
    if (__builtin_expect(__all((pmax - m_reg) * SCALE <= THR), 1)) { mn = m_reg; alpha = 1.f; }
    else { mn = fmaxf(m_reg, pmax); alpha = __builtin_amdgcn_exp2f((m_reg - mn) * C2); m_reg = mn; }
    const float mnL = -mn * C2;
#pragma unroll
    for (int r = 0; r < 16; ++r) p0[r] = fmaf(p0[r], C2, mnL);
#pragma unroll
    for (int r = 0; r < 16; ++r) p1[r] = fmaf(p1[r], C2, mnL);
#pragma unroll
    for (int r = 0; r < 16; ++r) p0[r] = __builtin_amdgcn_exp2f(p0[r]);
}
__device__ __forceinline__ void finishSM(f32x16& p0, f32x16& p1, float alpha, float& l_reg, bf16x8& pa0, bf16x8& pa1, bf16x8& pa2, bf16x8& pa3) {
#pragma unroll
    for (int r = 0; r < 16; ++r) p1[r] = __builtin_amdgcn_exp2f(p1[r]);
    float ps = 0;
#pragma unroll
    for (int r = 0; r < 16; ++r) ps += p0[r];
#pragma unroll
    for (int r = 0; r < 16; ++r) ps += p1[r];
    { auto rr = __builtin_amdgcn_permlane32_swap(__float_as_uint(ps), __float_as_uint(ps), false, false);
      ps = __uint_as_float(rr[0]) + __uint_as_float(rr[1]); }
    l_reg = l_reg * alpha + ps;
#define PK4(P, B_, OUT) do { unsigned a0 = cvt_pk_bf16(P[B_+0], P[B_+1]), a1 = cvt_pk_bf16(P[B_+2], P[B_+3]);                          \
        unsigned b0 = cvt_pk_bf16(P[B_+4], P[B_+5]), b1 = cvt_pk_bf16(P[B_+6], P[B_+7]);                                             \
        auto r0 = __builtin_amdgcn_permlane32_swap(a0, b0, false, false); auto r1 = __builtin_amdgcn_permlane32_swap(a1, b1, false, false); \
        u32x4 w = {r0[0], r1[0], r0[1], r1[1]}; OUT = *reinterpret_cast<bf16x8*>(&w); } while (0)
    PK4(p0, 0, pa0); PK4(p0, 8, pa1); PK4(p1, 0, pa2); PK4(p1, 8, pa3);
#undef PK4
}
template <int MODE, int KB>
__device__ __forceinline__ void qkt(f32x16& p0, f32x16& p1, const char* K_lds, int kcb, int r32, int hi, const bf16x8* qr, bool act, const float* cumk, float bq) {
    constexpr int ND0 = MODE == 0 ? 8 : 4;
    if (MODE == 1 && !act) { const float NEG = -__builtin_inff();
#pragma unroll
        for (int r = 0; r < 16; ++r) { p0[r] = NEG; p1[r] = NEG; } return; }
    if constexpr (MODE == 0) {
#pragma unroll
        for (int q = 0; q < 4; ++q) { const f32x4 c0 = *(const f32x4*)(cumk + 8 * q), c1 = *(const f32x4*)(cumk + 32 + 8 * q);
#pragma unroll
            for (int e = 0; e < 4; ++e) { p0[4 * q + e] = bq - c0[e]; p1[4 * q + e] = bq - c1[e]; } }
    } else { p0 = f32x16{}; p1 = f32x16{}; }
    const char* kb[4];
#pragma unroll
    for (int dd = 0; dd < 4; ++dd) kb[dd] = K_lds + KB * SHM_K + kcb + KSWZ(r32, (dd * 16 + hi * 8) * 2);
#pragma unroll
    for (int d0 = 0; d0 < ND0; ++d0) { const char* a = kb[d0 & 3] + (d0 >> 2) * 128;
        bf16x8 b0 = *reinterpret_cast<const bf16x8*>(a);
        bf16x8 b1 = *reinterpret_cast<const bf16x8*>(a + 32 * 256);
        p0 = __builtin_amdgcn_mfma_f32_32x32x16_bf16(b0, qr[d0], p0, 0, 0, 0);
        p1 = __builtin_amdgcn_mfma_f32_32x32x16_bf16(b1, qr[d0], p1, 0, 0, 0); }
}
template <int MODE, int VB>
__device__ __forceinline__ void pv_tile(f32x16* o, int vb0, bf16x8 pa0, bf16x8 pa1, bf16x8 pa2, bf16x8 pa3, bool act) {
    if (MODE == 1 && !act) return;
#define TRRD(dst, off) asm volatile("ds_read_b64_tr_b16 %0, %1 offset:%2" : "=&v"(dst) : "v"(vb0), "i"(off) : "memory")
#define PV_D0(d0) do { s16x4 l0, l1, l2, l3, h0, h1, h2, h3; constexpr int b_ = VB * SHM_V + v_rd_off(d0, 0, 0); \
        TRRD(l0, b_); TRRD(h0, b_ + 2048); TRRD(l1, b_ + 4096); TRRD(h1, b_ + 6144); TRRD(l2, b_ + 8192); TRRD(h2, b_ + 10240); TRRD(l3, b_ + 12288); TRRD(h3, b_ + 14336); \
        asm volatile("s_waitcnt lgkmcnt(0)" ::: "memory"); SBAR();   \
        o[d0] = __builtin_amdgcn_mfma_f32_32x32x16_bf16(pa0, (bf16x8){l0[0], l0[1], l0[2], l0[3], h0[0], h0[1], h0[2], h0[3]}, o[d0], 0, 0, 0);   \
        o[d0] = __builtin_amdgcn_mfma_f32_32x32x16_bf16(pa1, (bf16x8){l1[0], l1[1], l1[2], l1[3], h1[0], h1[1], h1[2], h1[3]}, o[d0], 0, 0, 0);   \
        o[d0] = __builtin_amdgcn_mfma_f32_32x32x16_bf16(pa2, (bf16x8){l2[0], l2[1], l2[2], l2[3], h2[0], h2[1], h2[2], h2[3]}, o[d0], 0, 0, 0);   \
        o[d0] = __builtin_amdgcn_mfma_f32_32x32x16_bf16(pa3, (bf16x8){l3[0], l3[1], l3[2], l3[3], h3[0], h3[1], h3[2], h3[3]}, o[d0], 0, 0, 0); } while (0)
    PV_D0(0); PV_D0(1); PV_D0(2); PV_D0(3);
#undef PV_D0
#undef TRRD
}

struct Blk { const bf16* Q; const bf16* K; const bf16* V; int P0; int kcb; int bh; };
struct Seam { bf16x8 qr[8]; bf16x8 st_v0, st_v1, st_k0, st_k1; };
struct EpiCtx { bf16* out; int ld; };
#define ROW(p, k0, rr) ((p) + (size_t)((k0) + (rr)) * LDP + sc)
#define VMW() asm volatile("s_waitcnt vmcnt(0)" ::: "memory")
#define VMWN(n) asm volatile("s_waitcnt vmcnt(%0)" :: "i"(n) : "memory")
#define SLOAD_H(Kp, Vp, k0) do { S.st_v0 = load8(ROW(Vp, k0, sr)); S.st_v1 = load8(ROW(Vp, k0, 32 + sr));              \
                         S.st_k0 = load8(ROW(Kp, k0, sr)); S.st_k1 = load8(ROW(Kp, k0, 32 + sr)); } while (0)
#define SWRITE_HK(bf) do { *(bf16x8*)(K_lds + (bf) * SHM_K + kws) = S.st_k0; *(bf16x8*)(K_lds + (bf) * SHM_K + kws + 32 * 256) = S.st_k1; } while (0)
#define SWRITE_HV(bf) do { *(bf16x8*)(V_lds + (bf) * SHM_V + vst0) = S.st_v0; *(bf16x8*)(V_lds + (bf) * SHM_V + vst1) = S.st_v1; } while (0)
#define SWRITE_H(bf) do { SWRITE_HV(bf); SWRITE_HK(bf); } while (0)
template <int MODE>
__device__ __forceinline__ void attn_prime(const Blk& cur, char* lds, Seam& S) {
    constexpr int ND0 = 8;
    int tid = threadIdx.x; asm volatile("" : "+v"(tid));
    const int wid = __builtin_amdgcn_readfirstlane(tid >> 6), lane = tid & 63, r32 = lane & 31, hi = lane >> 5;
    const int sr = tid >> 4, sc = (tid & 15) * 8, kws = KSWZ(sr, sc * 2); char* K_lds = lds + 2 * SHM_V;
#pragma unroll
    for (int d0 = 0; d0 < ND0; ++d0) S.qr[d0] = load8(cur.Q + (size_t)(wid * QBLK + r32) * LDP + d0 * 16 + hi * 8);
    SLOAD_H(cur.K, cur.V, 0); VMW(); SWRITE_HK(0);
    __syncthreads();
}
template <int MODE>
__device__ __forceinline__ void attn_block(const Blk& cur, const Blk& nxt, char* lds, Seam& S, const EpiCtx& E, const float* aux) {
    constexpr int ND0 = 8;
    int tid = threadIdx.x; asm volatile("" : "+v"(tid));
    const int wid = __builtin_amdgcn_readfirstlane(tid >> 6), lane = tid & 63, r32 = lane & 31, hi = lane >> 5;
    const int NT = cur.P0 / KVBLK + 4;
    const int qlo = cur.P0 + wid * QBLK, qm = qlo + r32 - 4 * hi;
    char* V_lds = lds; char* K_lds = lds + 2 * SHM_V;
    float* ws = (float*)(lds + OFF_WS) + wid * 64; float* li_l = ws, * al_l = ws + 32;
    float m_reg = -1e30f, l_reg = 0; f32x16 o[4] = {};
    const int sr = tid >> 4, sc = (tid & 15) * 8, vst0 = v_st(sr, sc), vst1 = v_st(32 + sr, sc), kws = KSWZ(sr, sc * 2);
    const int vb0 = (int)(uintptr_t)V_lds + v_rd_base(lane);
    const bf16* Kh = cur.K; const bf16* Vh = cur.V;
    const int kcb = cur.kcb;
    float bq = 0.f; if (MODE == 0) bq = aux[qlo + r32];
    const float* cumk0 = aux + 4 * hi;
#define RESC(a) do { if (__any((a) < 1.f)) { if (hi == 0) al_l[r32] = (a); asm volatile("s_waitcnt lgkmcnt(0)" ::: "memory");              \
                     for (int d_ = 0; d_ < 4; ++d_) for (int r = 0; r < 16; ++r) o[d_][r] *= al_l[crow(r, hi)]; } } while (0)
#define KBASE(t) ((t) * KVBLK)
#define ACT(t) (MODE == 0 ? true : (KBASE(t) <= (qlo & ~63)))
#define MASKT(P0_, P1_, t) do { const int kb_ = KBASE(t); \
        if (MODE == 0) { if (kb_ + KVBLK - 1 > qlo) mask_causal(P0_, P1_, qm - kb_); } \
        else { if (ACT(t) && kb_ + 191 > qlo) bias_t5(P0_, P1_, kb_ + 4 * hi - (qlo + r32), aux); } } while (0)
#define SEAM_K0() do { VMWN(ND0); SWRITE_HK(0); SBAR(); } while (0)
    f32x16 pA0, pA1, pB0, pB1; float mnA, mnB, alA, alB; bf16x8 pa0, pa1, pa2, pa3;
    SWRITE_HV(0); SBAR();
    SLOAD_H(Kh, Vh, KBASE(1));
    SBAR(); qkt<MODE, 0>(pA0, pA1, K_lds, kcb, r32, hi, S.qr, ACT(0), cumk0 + KBASE(0), bq);
    MASKT(pA0, pA1, 0); partialSM<MODE>(pA0, pA1, m_reg, mnA, alA);
    VMW(); SWRITE_H(1);
    __syncthreads();
#define HALF_STEP(PX0, PX1, mnX, alX, PY0, PY1, alY, t, KB, VB, SB) do {                                                      \
        SBAR(); qkt<MODE, KB>(PX0, PX1, K_lds, kcb, r32, hi, S.qr, ACT(t), cumk0 + KBASE(t), bq);                            \
        finishSM(PY0, PY1, alY, l_reg, pa0, pa1, pa2, pa3); SBAR();                                                           \
        if ((t) + 1 < NT) { SLOAD_H(Kh, Vh, KBASE((t) + 1)); SBAR(); }                                                        \
        pv_tile<MODE, VB>(o, vb0, pa0, pa1, pa2, pa3, ACT((t) - 1)); MASKT(PX0, PX1, (t)); partialSM<MODE>(PX0, PX1, m_reg, mnX, alX);   \
        __syncthreads();                                                                                                      \
        if ((t) + 1 < NT) { VMW(); SWRITE_H(SB); }                                                                            \
        RESC(alX); __syncthreads(); } while (0)
    for (int t = 1; t + 1 < NT; t += 2) {
        HALF_STEP(pB0, pB1, mnB, alB, pA0, pA1, alA, t, 1, 0, 0);
        HALF_STEP(pA0, pA1, mnA, alA, pB0, pB1, alB, t + 1, 0, 1, 1);
    }
    SBAR(); qkt<MODE, 1>(pB0, pB1, K_lds, kcb, r32, hi, S.qr, ACT(NT - 1), cumk0 + KBASE(NT - 1), bq); SBAR();
    SLOAD_H(nxt.K, nxt.V, 0); SBAR();
#pragma unroll
    for (int d0 = 0; d0 < ND0; ++d0) S.qr[d0] = load8(nxt.Q + (size_t)(wid * QBLK + r32) * LDP + d0 * 16 + hi * 8);
    SBAR();
    finishSM(pA0, pA1, alA, l_reg, pa0, pa1, pa2, pa3); SBAR();
    pv_tile<MODE, 0>(o, vb0, pa0, pa1, pa2, pa3, ACT(NT - 2));
    MASKT(pB0, pB1, NT - 1); partialSM<MODE>(pB0, pB1, m_reg, mnB, alB); __syncthreads(); RESC(alB);
    finishSM(pB0, pB1, alB, l_reg, pa0, pa1, pa2, pa3); SBAR(); pv_tile<MODE, 1>(o, vb0, pa0, pa1, pa2, pa3, ACT(NT - 1));
    SBAR(); SEAM_K0();
    if (hi == 0) li_l[r32] = l_reg; asm volatile("s_waitcnt lgkmcnt(0)" ::: "memory");
    float rli[16];
#pragma unroll
    for (int r = 0; r < 16; ++r) rli[r] = __builtin_amdgcn_rcpf(li_l[crow(r, hi)]);
    {
        bf16* Ow = E.out + (size_t)(wid * QBLK) * E.ld;
        bf16* stg = (bf16*)(lds + OFF_OST) + wid * 2048;
#pragma unroll
        for (int half = 0; half < 2; ++half) {
#pragma unroll
            for (int r = 0; r < 16; ++r) { const int orow = crow(r, hi);
#pragma unroll
                for (int dd = 0; dd < 2; ++dd) stg[orow * 64 + dd * 32 + r32] = (bf16)(cvt_pk_bf16(o[2 * half + dd][r] * rli[r], 0.f) & 0xffffu); }
            asm volatile("s_waitcnt lgkmcnt(0)" ::: "memory");
#pragma unroll
            for (int i = 0; i < 4; ++i) { const int row = i * 8 + (lane >> 3), ch = lane & 7;
                const u32x4 v = *(const u32x4*)(stg + row * 64 + ch * 8);
                *(u32x4*)(Ow + (size_t)row * E.ld + half * 64 + ch * 8) = v; }
            asm volatile("s_waitcnt lgkmcnt(0)" ::: "memory");
        }
    }
    __syncthreads();
#undef RESC
#undef KBASE
#undef ACT
#undef MASKT
#undef SEAM_K0
#undef HALF_STEP
}
#undef ROW
#undef VMW
#undef VMWN
#undef SLOAD_H
#undef SWRITE_HK
#undef SWRITE_HV
#undef SWRITE_H
}

#define XB_TMO      128
#define XB_XCNT(j)  (256  + 64 * (j))
#define XB_XSUB(j)  (1280 + 64 * (j))
#define XB_XGEN(j)  (2304 + 64 * (j))
#define XB_TOP      3328
#define XB_TOPGEN   3392
#define XCD_BAR_WORDS 3456
#define XB_SPIN_CAP (1u << 18)
__device__ __forceinline__ unsigned xb_ld(unsigned* p)              { return __hip_atomic_load(p, __ATOMIC_RELAXED, __HIP_MEMORY_SCOPE_AGENT); }
__device__ __forceinline__ unsigned xb_add(unsigned* p, unsigned v) { return __hip_atomic_fetch_add(p, v, __ATOMIC_RELAXED, __HIP_MEMORY_SCOPE_AGENT); }
__device__ __forceinline__ unsigned xb_xcc_id() { return (unsigned)__builtin_amdgcn_s_getreg((3 << 11) | 20) & 0xFu; }
#define XB_SPIN(cond, bar) do { unsigned _sp = 0; while (cond) { __builtin_amdgcn_s_sleep(1); \
    if ((++_sp & 255u) == 0u) { if (xb_ld(&(bar)[XB_TMO])) break; if (_sp > XB_SPIN_CAP) { atomicAdd(&(bar)[XB_TMO], 1u); break; } } } } while (0)
struct XcdBarrier { unsigned* bar; unsigned x; volatile LAS unsigned* st; };
__device__ __forceinline__ XcdBarrier xcd_barrier_post(unsigned* bar, volatile LAS unsigned* st) {
    XcdBarrier b; b.bar = bar; b.x = xb_xcc_id(); b.st = st;
    if (threadIdx.x == 0) (void)xb_add(&bar[XB_XCNT(b.x)], 1u);
    return b;
}
__device__ __forceinline__ void xcd_barrier_complete(unsigned* bar, unsigned x, unsigned& nloc, unsigned& nx) {
    const unsigned G = gridDim.x * gridDim.y * gridDim.z;
    unsigned sum, cnt, mine, sp = 0u;
    for (;;) {
        sum = 0u; cnt = 0u; mine = 0u;
#pragma unroll
        for (unsigned j = 0; j < 16; ++j) { const unsigned c = xb_ld(&bar[XB_XCNT(j)]); sum += c; cnt += (c > 0u) ? 1u : 0u; mine = (j == x) ? c : mine; }
        if (sum == G) break;
        __builtin_amdgcn_s_sleep(1);
        if ((++sp & 255u) == 0u) { if (xb_ld(&bar[XB_TMO])) break; if (sp > XB_SPIN_CAP) { atomicAdd(&bar[XB_TMO], 1u); break; } }
    }
    nloc = mine > 0u ? mine : 1u; nx = cnt > 0u ? cnt : 1u;
}
__device__ __forceinline__ void xcd_barrier(const XcdBarrier& b) {
    asm volatile("s_waitcnt vmcnt(0)" ::: "memory");
    __syncthreads();
    if (threadIdx.x == 0) {
        unsigned* bar = b.bar;
        __builtin_amdgcn_s_waitcnt(0);
        unsigned nloc = b.st[0], nx = b.st[1];
        if (nloc == 0u) { xcd_barrier_complete(bar, b.x, nloc, nx); b.st[0] = nloc; b.st[1] = nx; }
        const unsigned old = xb_add(&bar[XB_XSUB(b.x)], 1u);
        const unsigned gen = old / nloc;
        if (old + 1u == (gen + 1u) * nloc) {
            __builtin_amdgcn_fence(__ATOMIC_RELEASE, "agent");
            asm volatile("s_waitcnt vmcnt(0)" ::: "memory");
            const unsigned og = xb_add(&bar[XB_TOP], 1u);
            const unsigned tg = og / nx;
            if (og + 1u == (tg + 1u) * nx) xb_add(&bar[XB_TOPGEN], 1u);
            else XB_SPIN(xb_ld(&bar[XB_TOPGEN]) == tg, bar);
            __builtin_amdgcn_fence(__ATOMIC_ACQUIRE, "agent");
            xb_add(&bar[XB_XGEN(b.x)], 1u);
            asm volatile("s_waitcnt vmcnt(0)" ::: "memory");
        } else {
            XB_SPIN(xb_ld(&bar[XB_XGEN(b.x)]) == gen, bar);
            __builtin_amdgcn_fence(__ATOMIC_ACQUIRE, "agent");
            asm volatile("s_waitcnt vmcnt(0)" ::: "memory");
        }
    }
    __syncthreads();
}

struct Ctx { LAS unsigned char* lds; int tid, lane, wave, vcu, G; };

__device__ __forceinline__ void transpose_item(const float* W, int ld, bf16* WT, int ldt, int k0, int n0, int row_base, LAS float* scr, int lane, const float* gain) {
    float t_[32];
    { const float* wp = W + (size_t)(k0 + (lane >> 5)) * ld + n0 + (lane & 31);
#pragma unroll
      for (int i = 0; i < 32; ++i) t_[i] = wp[(size_t)(2 * i) * ld];
      if (gain) { const float* gp_ = gain + k0 + (lane >> 5);
#pragma unroll
          for (int i = 0; i < 32; ++i) t_[i] *= gp_[2 * i]; } }
#pragma unroll
    for (int i = 0; i < 32; ++i) scr[(2 * i + (lane >> 5)) * 33 + (lane & 31)] = t_[i];
    LDS_WAIT(); asm volatile("" ::: "memory");
    const int c = lane & 7;
#pragma unroll
    for (int j = 0; j < 4; ++j) { const int n = (lane >> 3) + 8 * j; const LAS float* s = scr + (8 * c) * 33 + n;
        u32x4 o; o.x = cvt_pk_bf16(s[0 * 33], s[1 * 33]); o.y = cvt_pk_bf16(s[2 * 33], s[3 * 33]); o.z = cvt_pk_bf16(s[4 * 33], s[5 * 33]); o.w = cvt_pk_bf16(s[6 * 33], s[7 * 33]);
        *(u32x4*)(WT + (size_t)(row_base + n) * ldt + k0 + 8 * c) = o; }
    LDS_WAIT(); asm volatile("" ::: "memory");
}

enum { I_X = 0, I_MEM, I_NORMG, I_F1IN, I_F1OUT, I_WIN, I_CONVW, I_CONVB, I_GATEW, I_GATEB, I_LAM, I_DLAM, I_SUBG, I_FBIAS, I_RELB, I_WOUT, I_WQ, I_WKV, I_WO, I_F2IN, I_F2OUT, I_OUT, I_WS };
typedef const __attribute__((address_space(4))) unsigned long long* kaptr_t;
__device__ __forceinline__ const float* karg(int i) { kaptr_t ka = (kaptr_t)__builtin_amdgcn_kernarg_segment_ptr(); asm volatile("" : "+s"(ka)); return (const float*)(const GAS float*)ka[i]; }
__device__ __forceinline__ void prologue_convert(const Ctx& F, unsigned char* ws, const int l0, const int l1, const bool xatt) {
    LAS float* scr = (LAS float*)(F.lds + F.wave * 16384);
    const int gw = F.vcu * 8 + F.wave, NGW = F.G * 8;
    const int njob = (l1 - l0) * 6 + (xatt ? DEPTH * 2 : 0);
    for (int job = 0; job < njob; ++job) {
        int l, k; if (job < (l1 - l0) * 6) { l = l0 + job / 6; k = job - (job / 6) * 6; } else { const int j2 = job - (l1 - l0) * 6; l = j2 >> 1; k = 6 + (j2 & 1); }
        const float* src; bf16* dst; int K, N, ld, kind = 0; const float* gain = nullptr;
        switch (k) {
            case 0:  src = karg(I_F1IN) + (size_t)l * DM * 2 * DFF;  dst = (bf16*)(ws + WS_W1I) + (size_t)l * 2 * DFF * DM; K = DM; N = 2 * DFF; ld = 2 * DFF; kind = 1; gain = karg(I_NORMG) + ((size_t)l * 8 + 0) * DM; break;
            case 1:  src = karg(I_F1OUT) + (size_t)l * DFF * DM;     dst = (bf16*)(ws + WS_W1O) + (size_t)l * DM * DFF;     K = DFF; N = DM; ld = DM; break;
            case 2:  src = karg(I_F2IN) + (size_t)l * DM * 2 * DFF;  dst = (bf16*)(ws + WS_W2I) + (size_t)l * 2 * DFF * DM; K = DM; N = 2 * DFF; ld = 2 * DFF; kind = 1; gain = karg(I_NORMG) + ((size_t)l * 8 + 6) * DM; break;
            case 3:  src = karg(I_F2OUT) + (size_t)l * DFF * DM;     dst = (bf16*)(ws + WS_W2O) + (size_t)l * DM * DFF;     K = DFF; N = DM; ld = DM; break;
            case 4:  src = karg(I_WIN) + (size_t)l * DM * DIN;           dst = (bf16*)(ws + WS_WIN) + (size_t)l * DINP * DM;    K = DM; N = DINP; ld = DIN; gain = karg(I_NORMG) + ((size_t)l * 8 + 2) * DM; break;
            case 5:  src = karg(I_WOUT) + (size_t)l * DM * DM;           dst = (bf16*)(ws + WS_WOUT) + (size_t)l * DM * DM;     K = DM; N = DM; ld = DM; break;
            case 6:  src = karg(I_WKV) + (size_t)l * DM * 2 * DM;  dst = (bf16*)(ws + WS_WKVT) + (size_t)l * 2 * DM * DM; K = DM; N = 2 * DM; ld = 2 * DM; break;
            default: src = karg(I_WO) + (size_t)l * DM * DM;       dst = (bf16*)(ws + WS_WOT) + (size_t)l * DM * DM;      K = DM; N = DM; ld = DM; break;
        }
        const int nblk = N / 32, nitems = (K / 64) * nblk;
        for (int it = gw; it < nitems; it += NGW) {
            const int kb = it / nblk, nb = it - kb * nblk, n0 = 32 * nb;
            int rb = n0;
            if (kind == 1) { const int up = n0 >= DFF, nn = n0 - up * DFF; rb = (nn >> 7) * 256 + up * 128 + (nn & 127); }
            transpose_item(src, ld, dst, K, 64 * kb, n0, rb, scr, F.lane, gain);
        }
    }
    for (int it = gw + l0 * 16 * 8; it < l1 * 16 * 8; it += NGW) { const int mat = it >> 3, sub = it & 7, kb = sub >> 2, nb = sub & 3;
        transpose_item(karg(I_GATEW) + (size_t)mat * 16384, 128, (bf16*)(ws + WS_GW) + (size_t)mat * 16384, 128, 64 * kb, 32 * nb, 32 * nb, scr, F.lane, nullptr); }
    if (xatt) {
    { const size_t n8 = (size_t)DEPTH * DM * DM / 8; bf16* d = (bf16*)(ws + WS_WQB); const float* wq = karg(I_WQ); const float* ng = karg(I_NORMG);
      for (size_t i = (size_t)gw * 64 + F.lane; i < n8; i += (size_t)NGW * 64) { const f32x4 a = *(const f32x4*)(wq + i * 8), b = *(const f32x4*)(wq + i * 8 + 4);
          const size_t row = i >> 8; const int l = (int)(row >> 11), din = (int)(row & 2047); const float g4 = ng[((size_t)l * 8 + 4) * DM + din];
          u32x4 o; o.x = cvt_pk_bf16(a[0] * g4, a[1] * g4); o.y = cvt_pk_bf16(a[2] * g4, a[3] * g4); o.z = cvt_pk_bf16(b[0] * g4, b[1] * g4); o.w = cvt_pk_bf16(b[2] * g4, b[3] * g4); *(u32x4*)(d + i * 8) = o; } }
    { const size_t n8 = (size_t)MROWS * DM / 8; bf16* d = (bf16*)(ws + WS_MEMB);
      for (size_t i = (size_t)gw * 64 + F.lane; i < n8; i += (size_t)NGW * 64) { const f32x4 a = *(const f32x4*)(karg(I_MEM) + i * 8), b = *(const f32x4*)(karg(I_MEM) + i * 8 + 4);
          u32x4 o; o.x = cvt_pk_bf16(a[0], a[1]); o.y = cvt_pk_bf16(a[2], a[3]); o.z = cvt_pk_bf16(b[0], b[1]); o.w = cvt_pk_bf16(b[2], b[3]); *(u32x4*)(d + i * 8) = o; } }
    }
}

__device__ __forceinline__ void norm_phase(const Ctx& F, const float* x32, const bf16* hb_in, const bf16* y, float wgt, const float* gpost, const float* gpre, bf16* hb_out, float* rs, float* out32, const float* wfl, float* fl) {
    LAS f32x4* wl = (LAS f32x4*)F.lds;
    if (wfl) { for (int k = F.tid; k < DM; k += 512) wl[k] = *(const f32x4*)(wfl + (size_t)k * DIN); }
    __syncthreads();
    const int gw = F.vcu * 8 + F.wave, NGW = F.G * 8;
    f32x4 gp[8], gq[8];
#pragma unroll
    for (int j = 0; j < 4; ++j)
#pragma unroll
        for (int q = 0; q < 2; ++q) { const int c = 8 * F.lane + 512 * j + 4 * q;
            gp[2 * j + q] = y ? *(const f32x4*)(gpost + c) : (f32x4){0.f, 0.f, 0.f, 0.f}; gq[2 * j + q] = wfl ? *(const f32x4*)(gpre + c) : (f32x4){0.f, 0.f, 0.f, 0.f}; }
    for (int m = gw; m < M; m += NGW) {
        const size_t ro = (size_t)m * DM + 8 * F.lane;
        f32x4 h[8];
        if (x32) {
#pragma unroll
            for (int j = 0; j < 4; ++j) { h[2 * j] = *(const f32x4*)(x32 + ro + 512 * j); h[2 * j + 1] = *(const f32x4*)(x32 + ro + 512 * j + 4); }
        } else {
#pragma unroll
            for (int j = 0; j < 4; ++j) { const u32x4 w = *(const u32x4*)(hb_in + ro + 512 * j);
                h[2 * j] = (f32x4){bflo(w.x), bfhi(w.x), bflo(w.y), bfhi(w.y)}; h[2 * j + 1] = (f32x4){bflo(w.z), bfhi(w.z), bflo(w.w), bfhi(w.w)}; }
        }
        if (y) {
            f32x4 v[8]; float ss = 0.f;
#pragma unroll
            for (int j = 0; j < 4; ++j) { const u32x4 w = *(const u32x4*)(y + ro + 512 * j);
                v[2 * j] = (f32x4){bflo(w.x), bfhi(w.x), bflo(w.y), bfhi(w.y)}; v[2 * j + 1] = (f32x4){bflo(w.z), bfhi(w.z), bflo(w.w), bfhi(w.w)}; }
#pragma unroll
            for (int j = 0; j < 8; ++j) ss += (v[j][0] * v[j][0] + v[j][1] * v[j][1]) + (v[j][2] * v[j][2] + v[j][3] * v[j][3]);
            const float r = wgt * __builtin_amdgcn_rsqf(wave_sum(ss, F.lane) * (1.f / DM) + EPS);
#pragma unroll
            for (int j = 0; j < 8; ++j) h[j] = h[j] + (v[j] * r) * gp[j];
        }
        if (out32) {
#pragma unroll
            for (int j = 0; j < 4; ++j) { *(f32x4*)(out32 + ro + 512 * j) = h[2 * j]; *(f32x4*)(out32 + ro + 512 * j + 4) = h[2 * j + 1]; }
        }
        if (hb_out) {
            float ss = 0.f;
#pragma unroll
            for (int j = 0; j < 8; ++j) ss += (h[j][0] * h[j][0] + h[j][1] * h[j][1]) + (h[j][2] * h[j][2] + h[j][3] * h[j][3]);
            const float r = __builtin_amdgcn_rsqf(wave_sum(ss, F.lane) * (1.f / DM) + EPS);
            if (F.lane == 0) rs[m] = r;
            float f0 = 0.f, f1 = 0.f, f2 = 0.f, f3 = 0.f;
#pragma unroll
            for (int j = 0; j < 4; ++j) { const f32x4 h0 = h[2 * j], h1 = h[2 * j + 1];
                u32x4 w; w.x = cvt_pk_bf16(h0[0], h0[1]); w.y = cvt_pk_bf16(h0[2], h0[3]); w.z = cvt_pk_bf16(h1[0], h1[1]); w.w = cvt_pk_bf16(h1[2], h1[3]);
                *(u32x4*)(hb_out + ro + 512 * j) = w;
                if (wfl) { const f32x4 n0 = (h0 * r) * gq[2 * j], n1 = (h1 * r) * gq[2 * j + 1];
#pragma unroll
                    for (int e = 0; e < 4; ++e) { const f32x4 wa = wl[8 * F.lane + 512 * j + e], wb = wl[8 * F.lane + 512 * j + 4 + e];
                        f0 += n0[e] * wa[0] + n1[e] * wb[0]; f1 += n0[e] * wa[1] + n1[e] * wb[1]; f2 += n0[e] * wa[2] + n1[e] * wb[2]; f3 += n0[e] * wa[3] + n1[e] * wb[3]; } } }
            if (wfl) { f0 = wave_sum(f0, F.lane); f1 = wave_sum(f1, F.lane); f2 = wave_sum(f2, F.lane); f3 = wave_sum(f3, F.lane);
                if (F.lane == 0) { fl[m] = f0; fl[M + m] = f1; fl[2 * M + m] = f2; fl[3 * M + m] = f3; } }
        }
    }
}

__device__ __forceinline__ void cum_wave(const float* fl, const float* fbias, float* cum, int bh, int lane) {
    const int b = bh >> 2, h = bh & 3; const float fb = fbias[h];
    const float* f = fl + (size_t)h * M + (size_t)b * SEQ + lane * 64;
    float v[64]; float run = 0.f;
#pragma unroll
    for (int i = 0; i < 16; ++i) { const f32x4 a = *(const f32x4*)(f + 4 * i);
#pragma unroll
        for (int e = 0; e < 4; ++e) { const float z = a[e] + fb; const float ls = fminf(z, 0.f) - log1p_small(fast_exp(-fabsf(z))); run += ls; v[4 * i + e] = run; } }
    float inc = run;
#pragma unroll
    for (int o = 1; o < 64; o <<= 1) { const float t = __uint_as_float((unsigned)__builtin_amdgcn_ds_bpermute(((lane - o) & 63) << 2, (int)__float_as_uint(inc))); if (lane >= o) inc += t; }
    const float excl = inc - run;
    float* c = cum + (size_t)bh * SEQ + lane * 64;
#pragma unroll
    for (int i = 0; i < 16; ++i) { f32x4 o4;
#pragma unroll
        for (int e = 0; e < 4; ++e) o4[e] = (v[4 * i + e] + excl) * (1.f / SCALE_FOX);
        *(f32x4*)(c + 4 * i) = o4; }
}

__device__ __forceinline__ void lru_local_item(int item, LAS unsigned char* xt, LAS unsigned char* ostg, const bf16* proj, const float* convw, const float* convb, const bf16* gwt, const float* gateb,
                                               const float* lam, bf16* HS, bf16* AP, float* TOT, int lane) {
    const int n = item & 7, ch = (item >> 3) & 127, b = item >> 10;
    const int t0 = ch * 32, c0 = n * 128, r32 = lane & 31, hi = lane >> 5;
    const size_t row0 = (size_t)b * SEQ + t0;
    {
        const int c = c0 + 2 * lane;
        f32x2 w[4];
#pragma unroll
        for (int k = 0; k < 4; ++k) w[k] = *(const f32x2*)(convw + k * LRUW + c);
        const f32x2 cb = *(const f32x2*)(convb + c);
        unsigned raw[35];
#pragma unroll
        for (int i = 0; i < 35; ++i) { const int t = t0 - 3 + i; raw[i] = (t >= 0) ? *(const unsigned*)(proj + (size_t)((long)row0 - 3 + i) * DINP + C_AX + c) : 0u; }
#pragma unroll
        for (int tl = 0; tl < 32; ++tl) {
            const float x0 = cb[0] + w[0][0] * bflo(raw[tl]) + w[1][0] * bflo(raw[tl + 1]) + w[2][0] * bflo(raw[tl + 2]) + w[3][0] * bflo(raw[tl + 3]);
            const float x1 = cb[1] + w[0][1] * bfhi(raw[tl]) + w[1][1] * bfhi(raw[tl + 1]) + w[2][1] * bfhi(raw[tl + 2]) + w[3][1] * bfhi(raw[tl + 3]);
            *(LAS unsigned*)(xt + tl * 272 + lane * 4) = cvt_pk_bf16(x0, x1); }
    }
    LDS_WAIT(); asm volatile("" ::: "memory");
    f32x16 acc[2][4];
#pragma unroll
    for (int g = 0; g < 2; ++g)
#pragma unroll
        for (int j = 0; j < 4; ++j) acc[g][j] = f32x16{};
    const bf16* gb = gwt + ((size_t)n * 128 + r32) * 128 + 8 * hi;
#pragma unroll
    for (int ks = 0; ks < 8; ++ks) {
        const bf16x8 a = *(const LAS bf16x8*)(xt + r32 * 272 + ks * 32 + hi * 16);
#pragma unroll
        for (int g = 0; g < 2; ++g)
#pragma unroll
            for (int j = 0; j < 4; ++j) { const bf16x8 bfr = *(const bf16x8*)(gb + (size_t)g * 131072 + j * 4096 + ks * 16);
                acc[g][j] = __builtin_amdgcn_mfma_f32_32x32x16_bf16(a, bfr, acc[g][j], 0, 0, 0); }
    }
#pragma unroll
    for (int j = 0; j < 4; ++j) {
        const int c = c0 + 32 * j + r32;
        const float gbr = gateb[c], gbi = gateb[LRUW + c], sp = log1p_small(fast_exp(-lam[c]));
#pragma unroll
        for (int r = 0; r < 16; ++r) { const int tl = crow(r, hi);
            const float x = __uint_as_float((unsigned)(*(const LAS unsigned short*)(xt + tl * 272 + (32 * j + r32) * 2)) << 16);
            const float rs = sigmoidf_(acc[0][j][r] + gbr), is = sigmoidf_(acc[1][j][r] + gbi);
            const float a = fast_exp(-8.f * rs * sp);
            acc[0][j][r] = a; acc[1][j][r] = __builtin_amdgcn_sqrtf(fmaxf(1.f - a * a, 0.f)) * (is * x); }
        float Ag[4], Bg[4], Ao[4], Bo[4], Ain[4], Hin[4];
#pragma unroll
        for (int q = 0; q < 4; ++q) { float A = acc[0][j][4 * q], H = acc[1][j][4 * q];
#pragma unroll
            for (int e = 1; e < 4; ++e) { const float a = acc[0][j][4 * q + e]; H = a * H + acc[1][j][4 * q + e]; A = a * A; acc[0][j][4 * q + e] = A; acc[1][j][4 * q + e] = H; }
            Ag[q] = A; Bg[q] = H; }
#pragma unroll
        for (int q = 0; q < 4; ++q) { Ao[q] = shx(Ag[q], 32, lane); Bo[q] = shx(Bg[q], 32, lane); }
        float Ac = 1.f, Hc = 0.f;
#pragma unroll
        for (int q = 0; q < 4; ++q) {
            const float a0 = hi ? Ao[q] : Ag[q], b0 = hi ? Bo[q] : Bg[q], a1 = hi ? Ag[q] : Ao[q], b1 = hi ? Bg[q] : Bo[q];
            const float Ac0 = Ac, Hc0 = Hc; Hc = a0 * Hc + b0; Ac = a0 * Ac;
            const float Ac1 = Ac, Hc1 = Hc; Hc = a1 * Hc + b1; Ac = a1 * Ac;
            Ain[q] = hi ? Ac1 : Ac0; Hin[q] = hi ? Hc1 : Hc0; }
        { LAS bf16* sh = (LAS bf16*)ostg; LAS bf16* sa = sh + 1024;
#pragma unroll
          for (int r = 0; r < 16; ++r) { const int q = r >> 2; const int tl = crow(r, hi);
              sh[tl * 32 + r32] = (bf16)(cvt_pk_bf16(acc[1][j][r] + acc[0][j][r] * Hin[q], 0.f) & 0xffffu);
              sa[tl * 32 + r32] = (bf16)(cvt_pk_bf16(acc[0][j][r] * Ain[q], 0.f) & 0xffffu); }
          LDS_WAIT(); asm volatile("" ::: "memory");
#pragma unroll
          for (int i = 0; i < 2; ++i) { const int slot = i * 64 + lane, row = slot >> 2, chunk = slot & 3; const size_t o = (row0 + row) * LRUW + c0 + 32 * j + chunk * 8;
              *(u32x4*)(HS + o) = *(const LAS u32x4*)(sh + row * 32 + chunk * 8); *(u32x4*)(AP + o) = *(const LAS u32x4*)(sa + row * 32 + chunk * 8); }
          LDS_WAIT(); asm volatile("" ::: "memory"); }
        if (hi == 0) { const size_t o = ((size_t)(b * 128 + ch) * 2) * LRUW + c; TOT[o] = Ac; TOT[o + LRUW] = Hc; }
    }
    LDS_WAIT(); asm volatile("" ::: "memory");
}
__device__ __forceinline__ void lru_fix_group(int item, LAS unsigned char* lds, const bf16* proj, const bf16* HS, const bf16* AP, const float* TOT, bf16* cat, int wave, int lane,
                                              const bf16* D1, const bf16* D2, const float* subg, float lam, float nscale) {
    const size_t crow0 = ((size_t)item * 8 + wave) * 8;
    u32x4 wa[8], wb[8];
#pragma unroll
    for (int q = 0; q < 8; ++q) { const size_t o = (crow0 + q) * 512 + 8 * lane; wa[q] = *(const u32x4*)(D1 + o); wb[q] = *(const u32x4*)(D2 + o); }
    const int cg = item & 15, g = (item >> 4) & 3, b = item >> 6;
    const int c = g * 256 + 4 * lane, ch0 = cg * 8;
    const size_t row0 = (size_t)b * SEQ + (size_t)(ch0 + wave) * 32;
    u32x2 hs2[16], ap2[16], ay[16];
#pragma unroll
    for (int u = 0; u < 16; ++u) { const size_t row = row0 + u; hs2[u] = *(const u32x2*)(HS + row * LRUW + c); ap2[u] = *(const u32x2*)(AP + row * LRUW + c); ay[u] = *(const u32x2*)(proj + row * DINP + C_AY + c); }
    const float* tp = TOT + ((size_t)(b * 128) * 2) * LRUW + c;
    LAS f32x4* sl = (LAS f32x4*)lds;
    {   f32x4 Ac = {1.f, 1.f, 1.f, 1.f}, Bc = {0.f, 0.f, 0.f, 0.f};
#pragma unroll
        for (int h2 = 0; h2 < 2; ++h2) {
            f32x4 A[8], B[8];
#pragma unroll
            for (int u = 0; u < 8; ++u) { const int uu = h2 * 8 + u; const int k = wave * cg + (uu < cg ? uu : 0);
                A[u] = *(const f32x4*)(tp + (size_t)k * 2 * LRUW); B[u] = *(const f32x4*)(tp + (size_t)k * 2 * LRUW + LRUW);
                if (uu >= cg) { A[u] = (f32x4){1.f, 1.f, 1.f, 1.f}; B[u] = (f32x4){0.f, 0.f, 0.f, 0.f}; } }
#pragma unroll
            for (int u = 0; u < 8; ++u) { Bc = A[u] * Bc + B[u]; Ac = A[u] * Ac; }
        }
        sl[(wave * 64 + lane) * 2] = Ac; sl[(wave * 64 + lane) * 2 + 1] = Bc;
    }
    __syncthreads();
    f32x4 H = {0.f, 0.f, 0.f, 0.f};
#pragma unroll
    for (int sidx = 0; sidx < 8; ++sidx) { const f32x4 As = sl[(sidx * 64 + lane) * 2], Bs = sl[(sidx * 64 + lane) * 2 + 1]; H = As * H + Bs; }
    {   f32x4 A[8], B[8];
#pragma unroll
        for (int u = 0; u < 8; ++u) { const int k = ch0 + (u < wave ? u : 0);
            A[u] = *(const f32x4*)(tp + (size_t)k * 2 * LRUW); B[u] = *(const f32x4*)(tp + (size_t)k * 2 * LRUW + LRUW);
            if (u >= wave) { A[u] = (f32x4){1.f, 1.f, 1.f, 1.f}; B[u] = (f32x4){0.f, 0.f, 0.f, 0.f}; } }
#pragma unroll
        for (int u = 0; u < 8; ++u) H = A[u] * H + B[u];
    }
#pragma unroll
    for (int half = 0; half < 2; ++half) {
        if (half == 1) {
#pragma unroll
            for (int u = 0; u < 16; ++u) { const size_t row = row0 + 16 + u; hs2[u] = *(const u32x2*)(HS + row * LRUW + c); ap2[u] = *(const u32x2*)(AP + row * LRUW + c); ay[u] = *(const u32x2*)(proj + row * DINP + C_AY + c); }
            const int cc = (8 * lane) & 127;
            const f32x4 g0 = *(const f32x4*)(subg + cc) * nscale, g1 = *(const f32x4*)(subg + cc + 4) * nscale;
#pragma unroll
            for (int q = 0; q < 8; ++q) {
                const f32x4 a0 = {bflo(wa[q].x), bfhi(wa[q].x), bflo(wa[q].y), bfhi(wa[q].y)}, a1 = {bflo(wa[q].z), bfhi(wa[q].z), bflo(wa[q].w), bfhi(wa[q].w)};
                const f32x4 b0 = {bflo(wb[q].x), bfhi(wb[q].x), bflo(wb[q].y), bfhi(wb[q].y)}, b1 = {bflo(wb[q].z), bfhi(wb[q].z), bflo(wb[q].w), bfhi(wb[q].w)};
                const f32x4 c0 = a0 - b0 * lam, c1 = a1 - b1 * lam;
                float ss = (c0[0] * c0[0] + c0[1] * c0[1]) + (c0[2] * c0[2] + c0[3] * c0[3]) + (c1[0] * c1[0] + c1[1] * c1[1]) + (c1[2] * c1[2] + c1[3] * c1[3]);
                ss += shx(ss, 1, lane); ss += shx(ss, 2, lane); ss += shx(ss, 4, lane); ss += shx(ss, 8, lane);
                const float rn = __builtin_amdgcn_rsqf(ss * (1.f / 128.f) + EPS);
                const f32x4 v0 = c0 * rn * g0, v1 = c1 * rn * g1;
                u32x4 w; w.x = cvt_pk_bf16(v0[0], v0[1]); w.y = cvt_pk_bf16(v0[2], v0[3]); w.z = cvt_pk_bf16(v1[0], v1[1]); w.w = cvt_pk_bf16(v1[2], v1[3]);
                *(u32x4*)(cat + (crow0 + q) * DM + CC_DIFF + 8 * lane) = w; }
        }
#pragma unroll
        for (int u = 0; u < 16; ++u) { const size_t row = row0 + half * 16 + u;
            const f32x4 hs = {bflo(hs2[u].x), bfhi(hs2[u].x), bflo(hs2[u].y), bfhi(hs2[u].y)}, ap = {bflo(ap2[u].x), bfhi(ap2[u].x), bflo(ap2[u].y), bfhi(ap2[u].y)};
            const f32x4 v = hs + ap * H;
            u32x2 w; w.x = cvt_pk_bf16(v[0] * gelu_tanh(bflo(ay[u].x)), v[1] * gelu_tanh(bfhi(ay[u].x))); w.y = cvt_pk_bf16(v[2] * gelu_tanh(bflo(ay[u].y)), v[3] * gelu_tanh(bfhi(ay[u].y)));
            *(u32x2*)(cat + row * DM + CC_LRU + c) = w; }
    }
    __syncthreads();
}
__device__ __forceinline__ void diff_combine_rows4(size_t row0, const bf16* D1, const bf16* D2, const float* subg, float lam, float nscale, bf16* cat, int lane) {
    f32x4 a0[4], a1[4], b0[4], b1[4];
#pragma unroll
    for (int q = 0; q < 4; ++q) { const size_t o = (row0 + q) * 512 + 8 * lane;
        const u32x4 wa = *(const u32x4*)(D1 + o), wb = *(const u32x4*)(D2 + o);
        a0[q] = (f32x4){bflo(wa.x), bfhi(wa.x), bflo(wa.y), bfhi(wa.y)}; a1[q] = (f32x4){bflo(wa.z), bfhi(wa.z), bflo(wa.w), bfhi(wa.w)};
        b0[q] = (f32x4){bflo(wb.x), bfhi(wb.x), bflo(wb.y), bfhi(wb.y)}; b1[q] = (f32x4){bflo(wb.z), bfhi(wb.z), bflo(wb.w), bfhi(wb.w)}; }
    const int c = (8 * lane) & 127;
    const f32x4 g0 = *(const f32x4*)(subg + c) * nscale, g1 = *(const f32x4*)(subg + c + 4) * nscale;
#pragma unroll
    for (int q = 0; q < 4; ++q) {
        const f32x4 c0 = a0[q] - b0[q] * lam, c1 = a1[q] - b1[q] * lam;
        float ss = (c0[0] * c0[0] + c0[1] * c0[1]) + (c0[2] * c0[2] + c0[3] * c0[3]) + (c1[0] * c1[0] + c1[1] * c1[1]) + (c1[2] * c1[2] + c1[3] * c1[3]);
        ss += shx(ss, 1, lane); ss += shx(ss, 2, lane); ss += shx(ss, 4, lane); ss += shx(ss, 8, lane);
        const float rn = __builtin_amdgcn_rsqf(ss * (1.f / 128.f) + EPS);
        const f32x4 v0 = c0 * rn * g0, v1 = c1 * rn * g1;
        u32x4 w; w.x = cvt_pk_bf16(v0[0], v0[1]); w.y = cvt_pk_bf16(v0[2], v0[3]); w.z = cvt_pk_bf16(v1[0], v1[1]); w.w = cvt_pk_bf16(v1[2], v1[3]);
        *(u32x4*)(cat + (row0 + q) * DM + CC_DIFF + 8 * lane) = w; }
}
__device__ __forceinline__ int fresh_tid(int wave) { int w_ = wave; asm volatile("" : "+s"(w_)); int t_; asm volatile("v_mbcnt_lo_u32_b32 %0, -1, 0\n\tv_mbcnt_hi_u32_b32 %0, -1, %0" : "=v"(t_)); return t_ + w_ * 64; }
__device__ __forceinline__ int dequeue(unsigned* head, volatile LAS unsigned* slot, int wave) {
    if (fresh_tid(wave) == 0) *slot = __hip_atomic_fetch_add(head, 1u, __ATOMIC_RELAXED, __HIP_MEMORY_SCOPE_AGENT);
    __syncthreads(); const int v = __builtin_amdgcn_readfirstlane((int)*slot); __syncthreads(); return v;
}

constexpr int PH_PRO = 3, PH_PER_LAYER = 14, NPH = PH_PRO + DEPTH * PH_PER_LAYER;
struct Args { const float* in[21]; float* out; unsigned char* ws; int ph_lo, ph_hi; };

#define WSB(off) (((unsigned char*)karg(I_WS)) + (off))
#define P_HB   ((bf16*)WSB(WS_XN))
#define P_RS   ((float*)WSB(WS_FL + 768 * 1024))
#define P_HFF  ((bf16*)WSB(WS_HFF))
#define P_PROJ ((bf16*)WSB(WS_PROJ))
#define P_CAT  ((bf16*)WSB(WS_CAT))
#define P_PB   ((bf16*)WSB(WS_PB))
#define P_Y    ((bf16*)WSB(WS_Y))
#define P_HS   ((bf16*)WSB(WS_HS))
#define P_AP   ((bf16*)WSB(WS_AP))
#define P_D1   ((bf16*)WSB(WS_D1))
#define P_D2   ((bf16*)WSB(WS_D2))
#define P_TOT  ((float*)WSB(WS_TOT))
#define P_FL   ((float*)WSB(WS_FL))
#define P_CUM  ((float*)WSB(WS_CUM))
#define P_H    ((float*)karg(I_OUT))

#define IN(k) (lo <= (k) && (k) < hi_ph)
#define SEAM(k) do { if (IN(k) && IN((k) + 1)) { XcdBarrier bb_; bb_.bar = (unsigned*)WSB(WS_CTL) + CW_BAR; bb_.x = xb_xcc_id(); bb_.st = (volatile LAS unsigned*)(ldsb + MISC_OFF) + 8; xcd_barrier(bb_); } } while (0)
#define OPQ int bx = (int)blockIdx.x; asm volatile("" : "+s"(bx)); int lq = l; asm volatile("" : "+s"(lq)); (void)lq; \
    Ctx F; { int w_ = wave_s; asm volatile("" : "+s"(w_)); int t_; asm volatile("v_mbcnt_lo_u32_b32 %0, -1, 0\n\tv_mbcnt_hi_u32_b32 %0, -1, %0" : "=v"(t_)); t_ += w_ * 64; F.lds = (LAS unsigned char*)lds; F.tid = t_; F.lane = t_ & 63; F.wave = __builtin_amdgcn_readfirstlane(t_ >> 6); \
             F.G = gridDim.x; F.vcu = (F.G % 8 == 0) ? (bx % 8) * (F.G / 8) + bx / 8 : bx; }

template <int L>
__device__ __forceinline__ void layer_phases(const int rep, const int lo, const int hi_ph, LAS unsigned char* const ldsb, const int wave_s, unsigned char* const lds) {
        constexpr int l = L;
        const int pb = PH_PRO + PH_PER_LAYER * l;
#define LIN(k) (IN(pb + (k)) && (rep == 0 || ((PROBE_DUP >> (k)) & 1u)))
#define LSEAM(k) do { if (rep == 0 ? (IN(pb + (k)) && IN(pb + (k) + 1)) : (((PROBE_DUP >> (k)) & 1u) != 0u)) { XcdBarrier bb_; bb_.bar = (unsigned*)WSB(WS_CTL) + CW_BAR; bb_.x = xb_xcc_id(); bb_.st = (volatile LAS unsigned*)(ldsb + MISC_OFF) + 8; xcd_barrier(bb_); } } while (0)
#define NG(k) (karg(I_NORMG) + ((size_t)lq * 8 + (k)) * DM)
        if (LIN(0)) { OPQ; pg8::Gemm g{DM, DM, DM};
            pg8::Ord S{(const char*)P_HB, (const char*)WSB(WS_W1I) + (size_t)lq * 2 * DFF * DM * 2, (size_t)256 * DM * 2, (size_t)256 * DM * 2, 0, M / 256, 2 * DFF / 256, F.G, bx, DFF, 128};
            pg8::EpiSwiGLU E{P_HFF, DFF, P_RS};
            pg8::gemm_phase<pg8::EpiSwiGLU, pg8::Ord, true>(F.lds, g, S, E); }
        LSEAM(0);
        if (LIN(1)) { OPQ; pg8::Gemm g{DFF, DFF, DFF};
            pg8::Ord S{(const char*)P_HFF, (const char*)WSB(WS_W1O) + (size_t)lq * DM * DFF * 2, (size_t)256 * DFF * 2, (size_t)256 * DFF * 2, 0, M / 256, DM / 256, F.G, bx, DM, 256};
            pg8::EpiBf16 E{P_Y, DM, 1.f, nullptr};
            pg8::gemm_phase<pg8::EpiBf16, pg8::Ord, true>(F.lds, g, S, E); }
        LSEAM(1);
        if (LIN(2)) { OPQ; norm_phase(F, nullptr, P_HB, P_Y, 0.5f, NG(1), NG(2), P_HB, P_RS, nullptr, karg(I_WIN) + (size_t)lq * DM * DIN + DINP, P_FL); }
        LSEAM(2);
        if (LIN(3)) { OPQ;
            if (bx < 16 && F.wave == 0) cum_wave(P_FL, karg(I_FBIAS) + lq * 4, P_CUM, bx, F.lane);
            pg8::Gemm g{DM, DM, DM};
            pg8::Ord S{(const char*)P_HB, (const char*)WSB(WS_WIN) + (size_t)lq * DINP * DM * 2, (size_t)256 * DM * 2, (size_t)256 * DM * 2, 0, M / 256, DINP / 256, F.G, bx, DINP, 256};
            pg8::EpiBf16 E{P_PROJ, DINP, 1.f, P_RS};
            pg8::gemm_phase<pg8::EpiBf16, pg8::Ord, true>(F.lds, g, S, E); }
        LSEAM(3);
        if (LIN(4)) { OPQ;
            char* alds = (char*)lds;
            unsigned* qhead = (unsigned*)WSB(WS_CTL) + CW_Q + 64 * lq;
            volatile LAS unsigned* qslot = (volatile LAS unsigned*)(ldsb + MISC_OFF) + 16;
            constexpr int N_LRU_ITEMS = 256, N_ITEMS = 256 + 768;
            {
                float* tb = (float*)(alds + att::OFF_T5); const float* relb = karg(I_RELB);
                for (int i = F.tid; i < 4 * 192; i += 512) { const int h = i / 192, t = i - 192 * h; float v = 0.f;
                    if (t >= 1) { const int rel = t - 128, n = rel < 0 ? -rel : rel;
                        int bk = n < 8 ? n : (n >= 91 ? 15 : n >= 64 ? 14 : n >= 46 ? 13 : n >= 32 ? 12 : n >= 23 ? 11 : n >= 16 ? 10 : n >= 12 ? 9 : 8);
                        if (rel > 0) bk += 16;
                        v = (relb[bk * 4 + h] - relb[15 * 4 + h]) * (1.f / SCALE_DIFF); }
                    tb[i] = v; }
            }
            int qi = dequeue(qhead, qslot, F.wave);
            while (qi < N_LRU_ITEMS) {
                for (int half = 0; half < 2; ++half)
                    lru_local_item(qi * 16 + half * 8 + F.wave, F.lds + F.wave * 8704, F.lds + att::OFF_OST + F.wave * 4096, P_PROJ, karg(I_CONVW) + (size_t)lq * 4 * LRUW, karg(I_CONVB) + (size_t)lq * LRUW, (const bf16*)WSB(WS_GW) + (size_t)lq * 2 * 8 * 16384,
                                   karg(I_GATEB) + (size_t)lq * 2 * LRUW, karg(I_LAM) + (size_t)lq * LRUW, P_HS, P_AP, P_TOT, F.lane);
                qi = dequeue(qhead, qslot, F.wave);
            }
#define MK_BLK(B_, E_, KIND_, i_) do { const int j_ = (i_) - N_LRU_ITEMS, s_ = j_ / 48, r_ = j_ - 48 * s_; KIND_ = r_ >> 4; const int bh_ = r_ & 15, qb_ = 15 - s_, b_ = bh_ >> 2, h_ = bh_ & 3; \
        const size_t rowb_ = (size_t)b_ * SEQ; const bf16* PR_ = P_PROJ; \
        if (KIND_ == 0) { B_.Q = PR_ + (rowb_ + (size_t)qb_ * 256) * DINP + C_FQ + h_ * 128; B_.K = PR_ + rowb_ * DINP + C_FK + h_ * 128; B_.V = PR_ + rowb_ * DINP + C_FV + h_ * 128; B_.kcb = 0; \
                          E_.out = P_CAT + (rowb_ + (size_t)qb_ * 256) * DM + CC_FOX + h_ * 128; E_.ld = DM; } \
        else { const int c_ = KIND_ - 1; B_.Q = PR_ + (rowb_ + (size_t)qb_ * 256) * DINP + C_DQ + h_ * 128 + c_ * 64; B_.K = PR_ + rowb_ * DINP + C_DK + h_ * 128; B_.V = PR_ + rowb_ * DINP + C_DV + h_ * 128; B_.kcb = c_ * 128; \
               E_.out = (c_ ? P_D2 : P_D1) + (rowb_ + (size_t)qb_ * 256) * 512 + h_ * 128; E_.ld = 512; } \
        B_.P0 = qb_ * 256; B_.bh = bh_; } while (0)
            if (qi < N_ITEMS) {
                att::Seam S;
                { att::Blk cur; att::EpiCtx Ec; int kc; MK_BLK(cur, Ec, kc, qi); (void)kc; att::attn_prime<0>(cur, alds, S); }
                for (;;) {
                    const int qn = dequeue(qhead, qslot, F.wave);
                    att::Blk cur, nxt; att::EpiCtx Ec, En; int kc, kn;
                    MK_BLK(cur, Ec, kc, qi);
                    { const int qx = qn < N_ITEMS ? qn : qi; MK_BLK(nxt, En, kn, qx); (void)kn; (void)En; }
                    if (kc == 0) {
                        const float* cg = P_CUM + (size_t)cur.bh * SEQ; float* cl = (float*)(alds + att::OFF_CUM); const int nk = cur.P0 + 256;
                        { const int t2 = fresh_tid(F.wave); for (int i = t2 * 4; i < nk; i += 2048) *(f32x4*)(cl + i) = *(const f32x4*)(cg + i); }
                        __syncthreads();
                        att::attn_block<0>(cur, nxt, alds, S, Ec, (const float*)(alds + att::OFF_CUM));
                    } else {
                        att::attn_block<1>(cur, nxt, alds, S, Ec, (const float*)(alds + att::OFF_T5) + 192 * (cur.bh & 3));
                    }
                    if (qn >= N_ITEMS) break;
                    qi = qn;
                }
            }
#undef MK_BLK
        }
        LSEAM(4);
        if (LIN(5)) { OPQ; const int gw = F.vcu * 8 + F.wave, NGW = F.G * 8;
            const float lam_init = lq == 0 ? 0.2f : lq == 1 ? 0.3555090675909693f : lq == 2 ? 0.4707130183435842f : 0.5560582041556405f;
            const float* dl = karg(I_DLAM) + (size_t)lq * 4 * 64;
            const float s1 = wave_sum(dl[F.lane] * dl[64 + F.lane], F.lane), s2 = wave_sum(dl[128 + F.lane] * dl[192 + F.lane], F.lane);
            const float lamv = fast_exp(s1) - fast_exp(s2) + lam_init;
            for (int it = F.vcu; it < BATCH * 4 * 16; it += F.G) lru_fix_group(it, F.lds, P_PROJ, P_HS, P_AP, P_TOT, P_CAT, F.wave, F.lane, P_D1, P_D2, karg(I_SUBG) + (size_t)lq * 128, lamv, 1.f - lam_init); }
        LSEAM(5);
        if (LIN(6)) { OPQ; pg8::Gemm g{DM, DM, DM};
            pg8::Ord S{(const char*)P_CAT, (const char*)WSB(WS_WOUT) + (size_t)lq * DM * DM * 2, (size_t)256 * DM * 2, (size_t)256 * DM * 2, 0, M / 256, DM / 256, F.G, bx, DM, 256};
            pg8::EpiBf16 E{P_Y, DM, 1.f, nullptr};
            pg8::gemm_phase<pg8::EpiBf16, pg8::Ord, true>(F.lds, g, S, E); }
        LSEAM(6);
        if (LIN(7)) { OPQ; norm_phase(F, nullptr, P_HB, P_Y, 1.f, NG(3), nullptr, P_HB, P_RS, nullptr, nullptr, nullptr); }
        LSEAM(7);
        if (LIN(8)) { OPQ; pg8::Gemm g{DM, DM, DM};
            pg8::Ord S{(const char*)P_HB, (const char*)WSB(WS_G) + (size_t)lq * 4 * 1024 * DM * 2, (size_t)256 * DM * 2, (size_t)256 * DM * 2, (size_t)1024 * DM * 2, M / 256, 4, F.G, bx, 1024, 256};
            pg8::EpiSoftmax E{P_PB, 1024, P_RS};
            pg8::gemm_phase<pg8::EpiSoftmax, pg8::Ord, false>(F.lds, g, S, E); }
        LSEAM(8);
        if (LIN(9)) { OPQ; pg8::Gemm g{1024, 1024, 1024};
            pg8::Ord S{(const char*)P_PB, (const char*)WSB(WS_UT) + (size_t)lq * 4 * DM * 1024 * 2, (size_t)256 * 1024 * 2, (size_t)256 * 1024 * 2, (size_t)DM * 1024 * 2, M / 256, DM / 256, F.G, bx, DM, 256};
            pg8::EpiBf16 E{P_Y, DM, 1.f, nullptr};
            pg8::gemm_phase<pg8::EpiBf16, pg8::Ord, true>(F.lds, g, S, E); }
        LSEAM(9);
        if (LIN(10)) { OPQ; norm_phase(F, nullptr, P_HB, P_Y, 1.f, NG(5), nullptr, P_HB, P_RS, nullptr, nullptr, nullptr); }
        LSEAM(10);
        if (LIN(11)) { OPQ; pg8::Gemm g{DM, DM, DM};
            pg8::Ord S{(const char*)P_HB, (const char*)WSB(WS_W2I) + (size_t)lq * 2 * DFF * DM * 2, (size_t)256 * DM * 2, (size_t)256 * DM * 2, 0, M / 256, 2 * DFF / 256, F.G, bx, DFF, 128};
            pg8::EpiSwiGLU E{P_HFF, DFF, P_RS};
            pg8::gemm_phase<pg8::EpiSwiGLU, pg8::Ord, true>(F.lds, g, S, E); }
        LSEAM(11);
        if (LIN(12)) { OPQ; pg8::Gemm g{DFF, DFF, DFF};
            pg8::Ord S{(const char*)P_HFF, (const char*)WSB(WS_W2O) + (size_t)lq * DM * DFF * 2, (size_t)256 * DFF * 2, (size_t)256 * DFF * 2, 0, M / 256, DM / 256, F.G, bx, DM, 256};
            pg8::EpiBf16 E{P_Y, DM, 1.f, nullptr};
            pg8::gemm_phase<pg8::EpiBf16, pg8::Ord, true>(F.lds, g, S, E); }
        LSEAM(12);
        if (LIN(13)) { OPQ; norm_phase(F, nullptr, P_HB, P_Y, 0.5f, NG(7), nullptr, (lq + 1 < DEPTH) ? P_HB : nullptr, P_RS, (lq + 1 < DEPTH) ? nullptr : P_H, nullptr, nullptr);
            if (l + 1 < DEPTH && rep == 0) { __syncthreads(); prologue_convert(F, WSB(0), lq + 1, lq + 2, false); } }
        LSEAM(13);
#undef LIN
#undef LSEAM
#undef NG
}

__global__ void __launch_bounds__(512, 2) trunk_fwd(Args args) {
    extern __shared__ __attribute__((aligned(16))) unsigned char lds[];
    LAS unsigned char* const ldsb = (LAS unsigned char*)lds;
    const int wave_s = __builtin_amdgcn_readfirstlane((int)threadIdx.x >> 6);
    for (int u = threadIdx.x; u < (LDS_BYTES - LDSCTL_OFF) / 4; u += 512) ((LAS unsigned*)(ldsb + LDSCTL_OFF))[u] = 0u;
    __syncthreads();
    const int lo = args.ph_lo, hi_ph = args.ph_hi;
    if (hi_ph - lo > 1) (void)xcd_barrier_post((unsigned*)WSB(WS_CTL) + CW_BAR, (volatile LAS unsigned*)(ldsb + MISC_OFF) + 8);
    { const int l = 0;
    if (IN(0)) { OPQ; prologue_convert(F, WSB(0), 0, 1, true); __syncthreads();
        norm_phase(F, karg(I_X), nullptr, nullptr, 0.f, nullptr, nullptr, P_HB, P_RS, nullptr, nullptr, nullptr); }
    SEAM(0);
    if (IN(1)) { OPQ; pg8::Gemm g{DM, DM, DM};
        pg8::Ord S{(const char*)WSB(WS_MEMB), (const char*)WSB(WS_WKVT), (size_t)256 * DM * 2, (size_t)256 * DM * 2, 0, MROWS / 256, DEPTH * 2 * DM / 256, F.G, bx, DEPTH * 2 * DM, 256};
        pg8::EpiBf16 E{(bf16*)WSB(WS_KVALL), DEPTH * 2 * DM, 1.f, nullptr};
        pg8::gemm_phase<pg8::EpiBf16, pg8::Ord, true>(F.lds, g, S, E); }
    SEAM(1);
    if (IN(2)) { OPQ;
        { pg8::Gemm g{DEPTH * 2 * DM, DM, 512}; pg8::OrdG S{(const char*)WSB(WS_KVALL), (const char*)WSB(WS_WQB), F.G, bx};
          pg8::EpiBf16 E{(bf16*)WSB(WS_G), DM, SCALE_X, nullptr};
          pg8::gemm_phase<pg8::EpiBf16, pg8::OrdG, true>(F.lds, g, S, E); }
        { pg8::Gemm g{DM, DEPTH * 2 * DM, 512}; pg8::OrdU S{(const char*)WSB(WS_KVALL), (const char*)WSB(WS_WOT), F.G, bx};
          pg8::EpiBf16 E{(bf16*)WSB(WS_UT), 1024, 1.f, nullptr};
          pg8::gemm_phase<pg8::EpiBf16, pg8::OrdU, true>(F.lds, g, S, E); }
    }
    SEAM(2);
    }

    layer_phases<0>(0, lo, hi_ph, ldsb, wave_s, lds); if (PROBE_DUP) layer_phases<0>(1, lo, hi_ph, ldsb, wave_s, lds);
    layer_phases<1>(0, lo, hi_ph, ldsb, wave_s, lds); if (PROBE_DUP) layer_phases<1>(1, lo, hi_ph, ldsb, wave_s, lds);
    layer_phases<2>(0, lo, hi_ph, ldsb, wave_s, lds); if (PROBE_DUP) layer_phases<2>(1, lo, hi_ph, ldsb, wave_s, lds);
    layer_phases<3>(0, lo, hi_ph, ldsb, wave_s, lds); if (PROBE_DUP) layer_phases<3>(1, lo, hi_ph, ldsb, wave_s, lds);
#undef IN
#undef SEAM
}

extern "C" void kernel_launch(void* const* d_in, const int* in_sizes, int n_in, void* d_out, int out_size, void* d_ws, size_t ws_size, hipStream_t stream) {
    static int grid = 0;
    if (grid == 0) {
        if (n_in != 21 || in_sizes[0] != M * DM || out_size != M * DM || ws_size < WS_END) { fprintf(stderr, "kernel_launch: unexpected shapes (n_in %d, in0 %d, out %d, ws %zu < %zu)\n", n_in, n_in > 0 ? in_sizes[0] : -1, out_size, ws_size, (size_t)WS_END); grid = -1; return; }
        int dev = 0, cus = 0, per_cu = 0;
        if (hipGetDevice(&dev) != hipSuccess || hipDeviceGetAttribute(&cus, hipDeviceAttributeMultiprocessorCount, dev) != hipSuccess) { grid = -1; return; }
        if (hipFuncSetAttribute((const void*)trunk_fwd, hipFuncAttributeMaxDynamicSharedMemorySize, LDS_BYTES) != hipSuccess) { fprintf(stderr, "kernel_launch: hipFuncSetAttribute failed\n"); grid = -1; return; }
        if (hipOccupancyMaxActiveBlocksPerMultiprocessor(&per_cu, (const void*)trunk_fwd, 512, LDS_BYTES) != hipSuccess || per_cu < 1) fprintf(stderr, "kernel_launch: occupancy query reports %d blocks per CU\n", per_cu);
        (void)hipGetLastError();
        grid = cus;
    }
    if (grid < 0) return;
    (void)hipMemsetAsync((char*)d_ws + WS_CTL, 0, CTL_ZERO_BYTES, stream);
    Args a{};
    for (int i = 0; i < 21; ++i) a.in[i] = (const float*)d_in[i];
    a.out = (float*)d_out; a.ws = (unsigned char*)d_ws;
#if MK_ONE_LAUNCH
    a.ph_lo = 0; a.ph_hi = NPH;
    hipLaunchKernelGGL(trunk_fwd, dim3(grid), dim3(512), LDS_BYTES, stream, a);
#else
    for (int p = 0; p < NPH; ++p) { a.ph_lo = p; a.ph_hi = p + 1; hipLaunchKernelGGL(trunk_fwd, dim3(grid), dim3(512), LDS_BYTES, stream, a); }
#endif
}
```
